# Optimizing an MI355X kernel written in HIP

```python
import jax, jax.numpy as jnp
from jax import lax
import numpy as np

D_MODEL = 1024
BATCH = 2
SEQ = 8192
DEPTH = 2
DEC_BATCH = 32
DEC_SEQ = 16
PAST_LEN = 1024

CHUNK = 64
W_A = 512
CONV_A_WIDTH = 3
N_HEADS = 4
HEAD_K = 128
HEAD_V = 128
W_QK = N_HEADS * HEAD_K
W_VV = N_HEADS * HEAD_V
W_QKV = 2 * W_QK + W_VV
CONV_QKV_WIDTH = 4
D_FF = 4 * D_MODEL
IN_SIZES = (W_A, W_A, W_A, W_QKV, W_VV, N_HEADS, N_HEADS, D_MODEL, D_MODEL)
IN_WIDTH = 3 * W_A + W_QKV + W_VV + 2 * N_HEADS + 2 * D_MODEL
EPS = 1e-6

kernel_name = "hybrid_stream_gconv_gdn_step"


def _in_offsets():
    offs, acc = [], 0
    for s in IN_SIZES[:-1]:
        acc += s
        offs.append(acc)
    return offs


def rmsnorm(x, g):
    xf = x.astype(jnp.float32)
    y = xf * lax.rsqrt(jnp.mean(xf * xf, axis=-1, keepdims=True) + EPS)
    return (y * g.astype(jnp.float32)).astype(x.dtype)


def l2norm(x):
    xf = x.astype(jnp.float32)
    return xf * lax.rsqrt(jnp.sum(xf * xf, axis=-1, keepdims=True) + EPS)


def causal_conv(x, buf, w):
    width = w.shape[0]
    L = x.shape[1]
    xp = jnp.concatenate([buf.astype(x.dtype), x], axis=1)
    y = xp[:, 0:L] * w[0]
    for i in range(1, width):
        y = y + xp[:, i:i + L] * w[i]
    return y, xp[:, xp.shape[1] - (width - 1):]


def gated_delta_rule(q, k, v, beta, g, S0, chunk):
    Bn, L, H, K = q.shape
    V = v.shape[-1]
    N = L // chunk
    f32 = jnp.float32

    def blk(t):
        t = t.astype(f32).reshape((Bn, N, chunk, H) + t.shape[3:])
        return jnp.moveaxis(t, 3, 1)

    q, k, v, beta, g = blk(q), blk(k), blk(v), blk(beta), blk(g)
    gc = jnp.cumsum(g, axis=-1)
    incl = jnp.tril(jnp.ones((chunk, chunk), dtype=bool))
    strict = jnp.tril(jnp.ones((chunk, chunk), dtype=bool), k=-1)
    diff = gc[..., :, None] - gc[..., None, :]
    decay = jnp.exp(jnp.where(incl, diff, -jnp.inf))
    kk = jnp.einsum('bhnik,bhnjk->bhnij', k, k)
    A = jnp.where(strict, kk * decay * beta[..., :, None], 0.0)
    eye = jnp.eye(chunk, dtype=f32)
    rhs = jnp.concatenate([v * beta[..., None], k * (beta * jnp.exp(gc))[..., None]], axis=-1)
    sol = lax.linalg.triangular_solve(eye + A, rhs, left_side=True, lower=True,
                                      unit_diagonal=True)
    w_v, w_k = sol[..., :V], sol[..., V:]
    P = jnp.einsum('bhnik,bhnjk->bhnij', q, k) * decay
    q_g = q * jnp.exp(gc)[..., None]
    k_t = k * jnp.exp(gc[..., -1:] - gc)[..., None]
    g_last = jnp.exp(gc[..., -1])

    def step(S, inp):
        wv, wk, Pb, qg, kt, gl = inp
        U = wv - jnp.einsum('bhck,bhkv->bhcv', wk, S)
        o = jnp.einsum('bhck,bhkv->bhcv', qg, S) + jnp.einsum('bhcd,bhdv->bhcv', Pb, U)
        S = S * gl[..., None, None] + jnp.einsum('bhck,bhcv->bhkv', kt, U)
        return S, o

    xs = tuple(jnp.moveaxis(t, 2, 0) for t in (w_v, w_k, P, q_g, k_t, g_last))
    S_fin, o = lax.scan(step, S0.astype(f32), xs)
    o = jnp.transpose(o, (1, 0, 3, 2, 4)).reshape(Bn, L, H, V)
    return o, S_fin


def hybrid_layer(x, buf_a, buf_qkv, S0, chunk, norm1_g, w_in, conv_a_w, w_a_out,
                 conv_qkv_w, a_log, dt_bias, onorm_g, w_b_out, w_o, norm2_g, w_up, w_down):
    Bn, L, _ = x.shape
    xn = rmsnorm(x, norm1_g)
    proj = xn @ w_in
    b_a, c_a, x_a, qkv, z, beta_raw, a_raw, gate_a, gate_b = jnp.split(proj, _in_offsets(), axis=-1)

    u, new_buf_a = causal_conv(c_a * x_a, buf_a, conv_a_w)
    y_a = (b_a * u) @ w_a_out

    qkv_c, new_buf_qkv = causal_conv(qkv, buf_qkv, conv_qkv_w)
    qkv_c = jax.nn.silu(qkv_c)
    q, k, v = jnp.split(qkv_c, [W_QK, 2 * W_QK], axis=-1)
    q = l2norm(q.reshape(Bn, L, N_HEADS, HEAD_K)) * (HEAD_K ** -0.5)
    k = l2norm(k.reshape(Bn, L, N_HEADS, HEAD_K))
    v = v.reshape(Bn, L, N_HEADS, HEAD_V).astype(jnp.float32)
    beta = jax.nn.sigmoid(beta_raw.astype(jnp.float32))
    g = -jnp.exp(a_log.astype(jnp.float32)) * jax.nn.softplus(
        a_raw.astype(jnp.float32) + dt_bias.astype(jnp.float32))
    o, S_new = gated_delta_rule(q, k, v, beta, g, S0, chunk)
    o = rmsnorm(o, onorm_g) * jax.nn.silu(z.reshape(Bn, L, N_HEADS, HEAD_V).astype(jnp.float32))
    y_b = o.reshape(Bn, L, W_VV).astype(x.dtype) @ w_b_out

    mixed = jax.nn.sigmoid(gate_a) * y_a + jax.nn.sigmoid(gate_b) * y_b
    h = x + mixed @ w_o
    f = jnp.square(jax.nn.relu(rmsnorm(h, norm2_g) @ w_up)) @ w_down
    return h + f, new_buf_a, new_buf_qkv, S_new


def run_trunk(x, bufs_a, bufs_qkv, Ss, chunk, norm1_g, w_in, conv_a_w, w_a_out,
              conv_qkv_w, a_log, dt_bias, onorm_g, w_b_out, w_o, norm2_g, w_up, w_down,
              final_g):
    na, nq, ns = [], [], []
    for l in range(DEPTH):
        x, ba, bq, S = hybrid_layer(x, bufs_a[l], bufs_qkv[l], Ss[l], chunk, norm1_g[l], w_in[l],
                                    conv_a_w[l], w_a_out[l], conv_qkv_w[l], a_log[l], dt_bias[l],
                                    onorm_g[l], w_b_out[l], w_o[l], norm2_g[l], w_up[l], w_down[l])
        na.append(ba)
        nq.append(bq)
        ns.append(S)
    return rmsnorm(x, final_g), jnp.stack(na), jnp.stack(nq), jnp.stack(ns)


def setup_inputs(seed: int = 0) -> dict:
    key = jax.random.key(seed)
    ks = jax.random.split(key, 24)
    f32 = jnp.float32
    nrm = lambda k, s, sc: jax.random.normal(k, s, f32) * sc
    dt = jnp.exp(jax.random.uniform(ks[10], (DEPTH, N_HEADS), f32, np.log(1e-3), np.log(1e-1)))
    return {
        "x_prompt": nrm(ks[0], (BATCH, SEQ, D_MODEL), 1.0),
        "x_sample": nrm(ks[1], (DEC_BATCH, DEC_SEQ, D_MODEL), 1.0),
        "state_conv_a": nrm(ks[2], (DEPTH, DEC_BATCH, CONV_A_WIDTH - 1, W_A), 1.0),
        "state_conv_qkv": nrm(ks[3], (DEPTH, DEC_BATCH, CONV_QKV_WIDTH - 1, W_QKV), 1.0),
        "state_delta": nrm(ks[4], (DEPTH, DEC_BATCH, N_HEADS, HEAD_K, HEAD_V), HEAD_K ** -0.5),
        "norm1_g": 1.0 + nrm(ks[5], (DEPTH, D_MODEL), 0.02),
        "w_in": nrm(ks[6], (DEPTH, D_MODEL, IN_WIDTH), D_MODEL ** -0.5),
        "conv_a_w": nrm(ks[7], (DEPTH, CONV_A_WIDTH, W_A), CONV_A_WIDTH ** -0.5),
        "w_a_out": nrm(ks[8], (DEPTH, W_A, D_MODEL), W_A ** -0.5),
        "conv_qkv_w": nrm(ks[9], (DEPTH, CONV_QKV_WIDTH, W_QKV), CONV_QKV_WIDTH ** -0.5),
        "a_log": jnp.log(jax.random.uniform(ks[11], (DEPTH, N_HEADS), f32, 1.0, 16.0)),
        "dt_bias": dt + jnp.log(-jnp.expm1(-dt)),
        "onorm_g": 1.0 + nrm(ks[12], (DEPTH, HEAD_V), 0.02),
        "w_b_out": nrm(ks[13], (DEPTH, W_VV, D_MODEL), W_VV ** -0.5),
        "w_o": nrm(ks[14], (DEPTH, D_MODEL, D_MODEL), D_MODEL ** -0.5),
        "norm2_g": 1.0 + nrm(ks[15], (DEPTH, D_MODEL), 0.02),
        "w_up": nrm(ks[16], (DEPTH, D_MODEL, D_FF), D_MODEL ** -0.5),
        "w_down": nrm(ks[17], (DEPTH, D_FF, D_MODEL), D_FF ** -0.5),
        "final_g": 1.0 + nrm(ks[18], (D_MODEL,), 0.02),
    }


def reference(x_prompt, x_sample, state_conv_a, state_conv_qkv, state_delta, norm1_g, w_in,
              conv_a_w, w_a_out, conv_qkv_w, a_log, dt_bias, onorm_g, w_b_out, w_o, norm2_g,
              w_up, w_down, final_g):
    nb = x_prompt.shape[0]
    zero_a = jnp.zeros((DEPTH, nb, CONV_A_WIDTH - 1, W_A), x_prompt.dtype)
    zero_qkv = jnp.zeros((DEPTH, nb, CONV_QKV_WIDTH - 1, W_QKV), x_prompt.dtype)
    zero_S = jnp.zeros((DEPTH, nb, N_HEADS, HEAD_K, HEAD_V), jnp.float32)
    y_prompt, p_a, p_qkv, p_S = run_trunk(
        x_prompt, zero_a, zero_qkv, zero_S, CHUNK, norm1_g, w_in, conv_a_w, w_a_out,
        conv_qkv_w, a_log, dt_bias, onorm_g, w_b_out, w_o, norm2_g, w_up, w_down, final_g)
    y_sample, s_a, s_qkv, s_S = run_trunk(
        x_sample, state_conv_a, state_conv_qkv, state_delta, x_sample.shape[1], norm1_g, w_in,
        conv_a_w, w_a_out, conv_qkv_w, a_log, dt_bias, onorm_g, w_b_out, w_o, norm2_g, w_up,
        w_down, final_g)
    return (y_prompt, y_sample,
            p_a.astype(state_conv_a.dtype), p_qkv.astype(state_conv_qkv.dtype),
            p_S.astype(state_delta.dtype),
            s_a.astype(state_conv_a.dtype), s_qkv.astype(state_conv_qkv.dtype),
            s_S.astype(state_delta.dtype))
```

```cpp
#include <hip/hip_runtime.h>
#include <hip/hip_cooperative_groups.h>
#include <cstdint>
#include <cstdio>
namespace cg = cooperative_groups;

#define LAS __attribute__((address_space(3)))
typedef unsigned short bf16_t;
typedef short bf16x8 __attribute__((ext_vector_type(8)));
typedef float f32x4 __attribute__((ext_vector_type(4)));
typedef float f32x16 __attribute__((ext_vector_type(16)));
typedef unsigned u32x4 __attribute__((ext_vector_type(4)));
typedef unsigned u32x2 __attribute__((ext_vector_type(2)));
#define DI __device__ __forceinline__

constexpr int TP = 16384, TS = 512, T = TP + TS, D = 1024, FF = 4096, SEQ = 8192, DSEQ = 16, DB = 32;
constexpr int LDP = 3584;
constexpr int C_BA = 0, C_CA = 512, C_XA = 1024, C_QKV = 1536, C_Z = 3072;
constexpr int NW1 = 5888;
constexpr int R_GA = 3840, R_GB = 4864;
constexpr int INW = 5640;
constexpr float EPS = 1e-6f;
constexpr size_t O_PA = (size_t)T * D, O_PQ = O_PA + 4096, O_PS = O_PQ + 18432, O_SA = O_PS + 262144, O_SQ = O_SA + 65536, O_SS = O_SQ + 294912;
constexpr size_t MiB = 1u << 20;
constexpr size_t WS_CTL = 0, CTL_BYTES = 1 * MiB;
constexpr size_t WS_W = 1 * MiB;
constexpr size_t W_IN = 0, W_A = (size_t)NW1 * D * 2, W_B = W_A + 1024 * 512 * 2, W_O = W_B + 1024 * 512 * 2, W_UP = W_O + 1024 * 1024 * 2, W_DN = W_UP + (size_t)FF * D * 2;
constexpr size_t WS_AB = 33 * MiB;
constexpr size_t WS_P = 66 * MiB;
constexpr size_t WS_PRE = 182 * MiB;
constexpr size_t WS_BG = 230 * MiB;
constexpr size_t WS_SB = 231 * MiB;
constexpr size_t WS_PART = 232 * MiB;
constexpr size_t OUT_OT = 40 * MiB;
constexpr int ITEM_BYTES = 74240, IT_WK = 0, IT_QG = 16384, IT_KT = 32768, IT_PP = 49152, IT_WV = 57344, IT_GL = 73728;
constexpr int LDS_BYTES = 159744 + 64, L_BARST = 159744;
constexpr size_t CTL_BAR = 768 * 1024;

typedef __bf16 bf16x2_t __attribute__((ext_vector_type(2)));
typedef float f32x2 __attribute__((ext_vector_type(2)));
DI unsigned pk2(float lo, float hi) { const f32x2 v = {lo, hi}; const bf16x2_t r = __builtin_convertvector(v, bf16x2_t); return __builtin_bit_cast(unsigned, r); }
DI unsigned f2bf(float f) { return pk2(f, 0.f) & 0xffffu; }
DI float bf2f(unsigned short b) { return __builtin_bit_cast(float, (unsigned)b << 16); }
DI float bflo(unsigned u) { return __builtin_bit_cast(float, u << 16); }
DI float bfhi(unsigned u) { return __builtin_bit_cast(float, u & 0xffff0000u); }
DI float sigm(float x) { return __builtin_amdgcn_rcpf(1.0f + __expf(-x)); }
DI int otid() { int t = threadIdx.x; asm volatile("" : "+v"(t)); return t; }
DI void lds_barrier() { asm volatile("s_waitcnt lgkmcnt(0)" ::: "memory"); __builtin_amdgcn_s_barrier(); asm volatile("" ::: "memory"); }
DI int perm16(int x) { return (x & ~15) | (((x >> 2) & 1) << 3) | (((x >> 3) & 1) << 2) | (x & 3); }

namespace pg8 {
constexpr int BM = 256, BK = 64, HALF = 128, HTB = HALF * BK * 2, STAGE_BYTES = 8 * HTB, NXCD = 8, WGM = 8;
__host__ __device__ __forceinline__ int lds_byte(int r, int c) { const int st = (r >> 4) * 2 + (c >> 5), rr = r & 15, cc = c & 31, ob = rr * 64 + cc * 2; return st * 1024 + (ob ^ (((ob >> 9) & 1) << 5)); }
__host__ __device__ __forceinline__ void stage_rc(int b, int& R, int& C) { const int st = b / 1024, sb = b % 1024, swz = sb ^ (((sb >> 9) & 1) << 5); R = (st >> 1) * 16 + swz / 64; C = (st & 1) * 32 + (swz % 64) / 2; }
__host__ __device__ __forceinline__ int perm32(int rho) { const int n = rho >> 4, i = rho & 15; return 8 * (i >> 2) + 4 * n + (i & 3); }
struct Unit { int pm, pn, ks; };
struct Gemm { const bf16_t* A; const bf16_t* Bt; int M, N, K, lda, ldb; };
struct StaticOrder {
    int nM, nN, nwg, G, c;
    __device__ void init(int M, int N, int G_, int c_) { nM = M / BM; nN = N / BM; nwg = nM * nN; G = G_; c = c_; }
    __device__ bool next(int i, Unit& u) const {
        const long L = (long)i * G + c; if (L >= nwg) return false;
        int wgid = (int)L; { const int q = nwg / NXCD, r = nwg % NXCD, xcd = wgid % NXCD, off = wgid / NXCD; wgid = (xcd < r ? xcd * (q + 1) : r * (q + 1) + (xcd - r) * q) + off; }
        const int nig = WGM * nN, gid = wgid / nig, fm = gid * WGM, gsz = (nM - fm) < WGM ? (nM - fm) : WGM;
        u.pm = fm + ((wgid % nig) % gsz); u.pn = (wgid % nig) / gsz; u.ks = 0; return true;
    }
};

struct ListOrder {
    int n, u0, u1, nM, nN;
    __device__ bool next(int i, Unit& u) const {
        if (i >= n) return false;
        int wgid = i == 0 ? u0 : u1; const int nwg = nM * nN;
        { const int q = nwg / NXCD, r = nwg % NXCD, xcd = wgid % NXCD, off = wgid / NXCD; wgid = (xcd < r ? xcd * (q + 1) : r * (q + 1) + (xcd - r) * q) + off; }
        const int nig = WGM * nN, gid = wgid / nig, fm = gid * WGM, gsz = (nM - fm) < WGM ? (nM - fm) : WGM;
        u.pm = fm + ((wgid % nig) % gsz); u.pn = (wgid % nig) / gsz; u.ks = 0; return true;
    }
};
struct UnitOrder { int n, pm, pn; __device__ bool next(int i, Unit& u) const { if (i >= n) return false; u.pm = pm; u.pn = pn; u.ks = 0; return true; } };
struct SplitOrder {
    int G, c, pm0, ns, n;
    __device__ bool next(int i, Unit& u) const { const int L = i * G + c; if (L >= n) return false; u.ks = L % ns; u.pn = (L / ns) & 3; u.pm = pm0 + L / (4 * ns); return true; }
};
template <class Epi, bool ALIGN_EPI, class Sched = StaticOrder>
__device__ __forceinline__ void gemm_phase(LAS unsigned char* lds, const Gemm g, const Sched& S, const Epi& E) {
    const int tid = otid(), wid = __builtin_amdgcn_readfirstlane(tid >> 6), lane = tid & 63, wr = wid >> 2, wc = wid & 3, fr = lane & 15, fq = lane >> 4;
    const int K = g.K, nt = K / BK;
    unsigned voffA[2], voffB[2];
#pragma unroll
    for (int i = 0; i < 2; ++i) { int R, C; stage_rc(tid * 16 + i * 8192, R, C); const int Rb = Epi::PERM ? ((R & ~31) + perm32(R & 31)) : R;
        voffA[i] = (unsigned)(R * g.lda + C) * 2u; voffB[i] = (unsigned)(Rb * g.ldb + C) * 2u; }
    const size_t kstep = (size_t)(BK * 2);
    const size_t hstepA = (size_t)HALF * g.lda * 2, hstepB = (size_t)HALF * g.ldb * 2;
    const size_t tstepA = 2 * hstepA, tstepB = 2 * hstepB;
    const unsigned ldsw = (unsigned)wid * 1024u;
    const int aoff = lds_byte(wr * 64 + fr, fq * 8), boff = lds_byte(wc * 32 + fr, fq * 8);
#define PG8_SA(b, h) (((b) * 2 + (h)) * HTB)
#define PG8_SB(b, h) ((4 + (b) * 2 + (h)) * HTB)
#define PG8_STAGE(bufoff, gbase, voff) do { _Pragma("unroll") for (int _i = 0; _i < 2; ++_i) \
        __builtin_amdgcn_global_load_lds((const unsigned*)((const char*)(gbase) + (voff)[_i]), (LAS unsigned*)(lds + (bufoff) + ldsw + _i * 8192), 16, 0, 0); } while (0)
#define PG8_LDA(dst, b, h) do { _Pragma("unroll") for (int m = 0; m < 4; ++m) _Pragma("unroll") for (int k = 0; k < 2; ++k) dst[m][k] = *(const LAS bf16x8*)(lds + PG8_SA(b, h) + aoff + m * 2048 + k * 1024); } while (0)
#define PG8_LDB(dst, b, h) do { _Pragma("unroll") for (int n = 0; n < 2; ++n) _Pragma("unroll") for (int k = 0; k < 2; ++k) dst[n][k] = *(const LAS bf16x8*)(lds + PG8_SB(b, h) + boff + n * 2048 + k * 1024); } while (0)
#define PG8_MMA(ai, bj, At, Bt) do { __builtin_amdgcn_s_setprio(1); _Pragma("unroll") for (int m = 0; m < 4; ++m) _Pragma("unroll") for (int n = 0; n < 2; ++n) _Pragma("unroll") for (int k = 0; k < 2; ++k) \
        acc[ai][bj][m][n] = __builtin_amdgcn_mfma_f32_16x16x32_bf16(Bt[n][k], At[m][k], acc[ai][bj][m][n], 0, 0, 0); __builtin_amdgcn_s_setprio(0); } while (0)
#define PG8_WAIT_V(n) asm volatile("s_waitcnt vmcnt(" #n ")" ::: "memory")
#define PG8_WAIT_L(n) asm volatile("s_waitcnt lgkmcnt(" #n ")" ::: "memory")
#define PG8_BAR __builtin_amdgcn_s_barrier()
#define PG8_SCHED __builtin_amdgcn_sched_barrier(0)
    Unit cur, nxt; int ui = 0;
    if (!S.next(0, cur)) return;
    f32x4 acc[2][2][4][2];
#pragma unroll
    for (int a = 0; a < 2; ++a)
#pragma unroll
        for (int b = 0; b < 2; ++b)
#pragma unroll
            for (int m = 0; m < 4; ++m)
#pragma unroll
                for (int n = 0; n < 2; ++n) acc[a][b][m][n] = (f32x4){0.f, 0.f, 0.f, 0.f};
    bf16x8 At[4][2], B0[2][2], B1[2][2];
    const size_t ksb = (size_t)K * 2;
    const char* cA = (const char*)g.A + (size_t)cur.pm * tstepA + cur.ks * ksb; const char* cB = (const char*)g.Bt + (size_t)cur.pn * tstepB + cur.ks * ksb;
    PG8_STAGE(PG8_SB(0, 0), cB, voffB); PG8_STAGE(PG8_SB(0, 1), cB + hstepB, voffB); PG8_STAGE(PG8_SA(0, 0), cA, voffA); PG8_STAGE(PG8_SA(0, 1), cA + hstepA, voffA);
    if (wr == 1) PG8_BAR;
    PG8_WAIT_V(2); PG8_BAR;
    PG8_STAGE(PG8_SB(1, 0), cB + kstep, voffB); PG8_STAGE(PG8_SA(1, 0), cA + kstep, voffA); PG8_STAGE(PG8_SB(1, 1), cB + hstepB + kstep, voffB);
    PG8_WAIT_V(6); PG8_BAR;
    for (;;) {
        const bool has_next = S.next(ui + 1, nxt);
        const char* nA = has_next ? (const char*)g.A + (size_t)nxt.pm * tstepA + nxt.ks * ksb : cA; const char* nB = has_next ? (const char*)g.Bt + (size_t)nxt.pn * tstepB + nxt.ks * ksb : cB;
        for (int t = 0; t < nt; t += 2) {
            const bool last = (t == nt - 2);
            const char* a1 = cA + (size_t)(t + 1) * kstep;
            const char* a2 = last ? nA : cA + (size_t)(t + 2) * kstep; const char* b2 = last ? nB : cB + (size_t)(t + 2) * kstep;
            const char* a3 = a2 + kstep; const char* b3 = b2 + kstep;
            const bool dead = last && !has_next;
            unsigned vA2[2], vB2[2];
            vA2[0] = dead ? 0u : voffA[0]; vA2[1] = dead ? 0u : voffA[1]; vB2[0] = dead ? 0u : voffB[0]; vB2[1] = dead ? 0u : voffB[1];
            PG8_LDB(B0, 0, 0); PG8_LDB(B1, 0, 1); PG8_SCHED; PG8_LDA(At, 0, 0); PG8_STAGE(PG8_SA(1, 1), a1 + hstepA, voffA);
            PG8_WAIT_V(8); PG8_WAIT_L(0); PG8_BAR; PG8_MMA(0, 0, At, B0); PG8_MMA(0, 1, At, B1); PG8_BAR; PG8_SCHED;
            PG8_LDA(At, 0, 1); PG8_STAGE(PG8_SB(0, 0), b2, vB2); PG8_STAGE(PG8_SB(0, 1), dead ? b2 : b2 + hstepB, vB2); PG8_STAGE(PG8_SA(0, 0), a2, vA2);
            PG8_WAIT_V(8); PG8_WAIT_L(0); PG8_BAR; PG8_MMA(1, 0, At, B0); PG8_MMA(1, 1, At, B1); PG8_BAR; PG8_SCHED;
            PG8_LDB(B0, 1, 0); PG8_LDB(B1, 1, 1); PG8_SCHED; PG8_LDA(At, 1, 0); PG8_STAGE(PG8_SA(0, 1), dead ? a2 : a2 + hstepA, vA2);
            PG8_WAIT_V(8); PG8_WAIT_L(0); PG8_BAR; PG8_MMA(0, 0, At, B0); PG8_MMA(0, 1, At, B1); PG8_BAR; PG8_SCHED;
            PG8_LDA(At, 1, 1); PG8_STAGE(PG8_SB(1, 0), dead ? b2 : b3, vB2); PG8_STAGE(PG8_SB(1, 1), dead ? b2 : b3 + hstepB, vB2); PG8_STAGE(PG8_SA(1, 0), dead ? a2 : a3, vA2);
            PG8_WAIT_V(8); PG8_WAIT_L(0); PG8_BAR; PG8_MMA(1, 0, At, B0); PG8_MMA(1, 1, At, B1); PG8_BAR; PG8_SCHED;
        }
        if constexpr (ALIGN_EPI) { if (wr == 0) PG8_BAR; }
        E(acc, cur, wr, wc, fr, fq);
        if (!has_next) break;
#pragma unroll
        for (int a = 0; a < 2; ++a)
#pragma unroll
            for (int b = 0; b < 2; ++b)
#pragma unroll
                for (int m = 0; m < 4; ++m)
#pragma unroll
                    for (int n = 0; n < 2; ++n) acc[a][b][m][n] = (f32x4){0.f, 0.f, 0.f, 0.f};
        cur = nxt; cA = nA; cB = nB; ++ui;
        if constexpr (ALIGN_EPI) { if (wr == 1) PG8_BAR; }
    }
    PG8_WAIT_V(0);
    if constexpr (!ALIGN_EPI) { if (wr == 0) PG8_BAR; }
    PG8_BAR;
#undef PG8_SA
#undef PG8_SB
#undef PG8_STAGE
#undef PG8_LDA
#undef PG8_LDB
#undef PG8_MMA
#undef PG8_WAIT_V
#undef PG8_WAIT_L
#undef PG8_BAR
#undef PG8_SCHED
}
}

typedef f32x4 Acc[2][2][4][2];
typedef unsigned long long ssq_t;
DI ssq_t ss_fix(float s) { return (ssq_t)(s * 16777216.0f); }
DI float rstd_of(const ssq_t* ss, int r) { return rsqrtf((float)ss[r] * (1.0f / (1024.0f * 16777216.0f)) + EPS); }

template <int MODE> struct EpiB {
    static constexpr bool PERM = true;
    bf16_t* O; int ldc; const ssq_t* ss; float* bg; const bf16_t* aux; int ldaux;
    DI void operator()(const Acc& acc, const pg8::Unit& u, int wr, int wc, int fr, int fq) const {
        const int row0 = u.pm * 256 + wr * 64 + fr, col0 = u.pn * 256 + wc * 32 + 8 * fq;
        if (MODE == 0 && u.pn == 14) {
            if (wc == 0 && fq == 0) {
#pragma unroll
                for (int ai = 0; ai < 2; ++ai)
#pragma unroll
                    for (int m = 0; m < 4; ++m) { const int r = row0 + ai * 128 + m * 16; const float rs = rstd_of(ss, r);
                        *(f32x4*)(bg + (size_t)r * 8) = acc[ai][0][m][0] * rs; *(f32x4*)(bg + (size_t)r * 8 + 4) = acc[ai][0][m][1] * rs; }
            }
            return;
        }
        float rsv[2][4];
#pragma unroll
        for (int ai = 0; ai < 2; ++ai)
#pragma unroll
            for (int m = 0; m < 4; ++m) rsv[ai][m] = (MODE <= 2) ? rstd_of(ss, row0 + ai * 128 + m * 16) : 1.f;
#pragma unroll
        for (int ai = 0; ai < 2; ++ai)
#pragma unroll
            for (int m = 0; m < 4; ++m) { const int r = row0 + ai * 128 + m * 16; const float rs = rsv[ai][m];
                bf16_t* rowp = O + (size_t)r * ldc + col0;
#pragma unroll
                for (int bj = 0; bj < 2; ++bj) { f32x4 v0 = acc[ai][bj][m][0], v1 = acc[ai][bj][m][1];
                    if (MODE <= 2) { v0 = v0 * rs; v1 = v1 * rs; }
                    if (MODE == 1) {
#pragma unroll
                        for (int e = 0; e < 4; ++e) { float a = fmaxf(v0[e], 0.f), b = fmaxf(v1[e], 0.f); v0[e] = a * a; v1[e] = b * b; } }
                    if (MODE == 2) {
#pragma unroll
                        for (int e = 0; e < 4; ++e) { v0[e] = sigm(v0[e]); v1[e] = sigm(v1[e]); } }
                    if (MODE == 3) { const u32x4 o = *(const u32x4*)(rowp + bj * 128);
                        v0[0] *= bflo(o.x); v0[1] *= bfhi(o.x); v0[2] *= bflo(o.y); v0[3] *= bfhi(o.y); v1[0] *= bflo(o.z); v1[1] *= bfhi(o.z); v1[2] *= bflo(o.w); v1[3] *= bfhi(o.w); }
                    if (MODE == 4) { const u32x4 o = *(const u32x4*)(rowp + bj * 128); const u32x4 s = *(const u32x4*)(aux + (size_t)r * ldaux + col0 + bj * 128);
                        v0[0] = bflo(o.x) + bflo(s.x) * v0[0]; v0[1] = bfhi(o.x) + bfhi(s.x) * v0[1]; v0[2] = bflo(o.y) + bflo(s.y) * v0[2]; v0[3] = bfhi(o.y) + bfhi(s.y) * v0[3];
                        v1[0] = bflo(o.z) + bflo(s.z) * v1[0]; v1[1] = bfhi(o.z) + bfhi(s.z) * v1[1]; v1[2] = bflo(o.w) + bflo(s.w) * v1[2]; v1[3] = bfhi(o.w) + bfhi(s.w) * v1[3]; }
                    u32x4 w; w.x = pk2(v0[0], v0[1]); w.y = pk2(v0[2], v0[3]); w.z = pk2(v1[0], v1[1]); w.w = pk2(v1[2], v1[3]);
                    *(u32x4*)(rowp + bj * 128) = w; } }
    }
};
struct EpiRes {
    static constexpr bool PERM = true;
    bf16_t* xb; ssq_t* ssn;
    DI void operator()(const Acc& acc, const pg8::Unit& u, int wr, int wc, int fr, int fq) const {
        const int row0 = u.pm * 256 + wr * 64 + fr, col0 = u.pn * 256 + wc * 32 + 8 * fq;
#pragma unroll
        for (int ai = 0; ai < 2; ++ai)
#pragma unroll
            for (int m = 0; m < 4; ++m) { const int r = row0 + ai * 128 + m * 16; float s = 0.f; bf16_t* rowp = xb + (size_t)r * D + col0;
#pragma unroll
                for (int bj = 0; bj < 2; ++bj) { const u32x4 o = *(const u32x4*)(rowp + bj * 128); f32x4 v0 = acc[ai][bj][m][0], v1 = acc[ai][bj][m][1];
                    v0[0] += bflo(o.x); v0[1] += bfhi(o.x); v0[2] += bflo(o.y); v0[3] += bfhi(o.y); v1[0] += bflo(o.z); v1[1] += bfhi(o.z); v1[2] += bflo(o.w); v1[3] += bfhi(o.w);
                    s += (v0[0] * v0[0] + v0[1] * v0[1]) + (v0[2] * v0[2] + v0[3] * v0[3]) + (v1[0] * v1[0] + v1[1] * v1[1]) + (v1[2] * v1[2] + v1[3] * v1[3]);
                    u32x4 w; w.x = pk2(v0[0], v0[1]); w.y = pk2(v0[2], v0[3]); w.z = pk2(v1[0], v1[1]); w.w = pk2(v1[2], v1[3]);
                    *(u32x4*)(rowp + bj * 128) = w; }
                s += __shfl_xor(s, 16); s += __shfl_xor(s, 32);
                if (fq == 0) __hip_atomic_fetch_add(ssn + r, ss_fix(s), __ATOMIC_RELAXED, __HIP_MEMORY_SCOPE_AGENT); }
    }
};
struct EpiPart {
    static constexpr bool PERM = false;
    float* part;
    DI void operator()(const Acc& acc, const pg8::Unit& u, int wr, int wc, int fr, int fq) const {
        const int row0 = u.pm * 256 + wr * 64 + fr - TP, col0 = u.pn * 256 + wc * 32 + 4 * fq; float* pp = part + (size_t)u.ks * TS * D;
#pragma unroll
        for (int ai = 0; ai < 2; ++ai)
#pragma unroll
            for (int m = 0; m < 4; ++m) { const int r = row0 + ai * 128 + m * 16;
#pragma unroll
                for (int bj = 0; bj < 2; ++bj)
#pragma unroll
                    for (int n = 0; n < 2; ++n) *(f32x4*)(pp + (size_t)r * D + col0 + bj * 128 + n * 16) = acc[ai][bj][m][n]; }
    }
};

#define XB_TMO      128
#define XB_XCNT(j)  (256  + 64 * (j))
#define XB_XSUB(j)  (1280 + 64 * (j))
#define XB_XGEN(j)  (2304 + 64 * (j))
#define XB_TOP      3328
#define XB_TOPGEN   3392
#define XB_SPIN_CAP (1u << 20)
DI unsigned xb_ld(unsigned* p)              { return __hip_atomic_load(p, __ATOMIC_RELAXED, __HIP_MEMORY_SCOPE_AGENT); }
DI unsigned xb_add(unsigned* p, unsigned v) { return __hip_atomic_fetch_add(p, v, __ATOMIC_RELAXED, __HIP_MEMORY_SCOPE_AGENT); }
DI unsigned xb_xcc_id() { return (unsigned)__builtin_amdgcn_s_getreg((3 << 11) | 20) & 0xFu; }
#define XB_SPIN(cond, bar) do { unsigned _sp = 0; while (cond) { \
    if ((++_sp & 255u) == 0u) { if (xb_ld(&(bar)[XB_TMO])) break; if (_sp > XB_SPIN_CAP) { atomicAdd(&(bar)[XB_TMO], 1u); break; } } } } while (0)
struct XcdBarrier { unsigned* bar; unsigned x; volatile LAS unsigned* st; };
DI XcdBarrier xcd_barrier_post(unsigned* bar, volatile LAS unsigned* st) {
    XcdBarrier b; b.bar = bar; b.x = xb_xcc_id(); b.st = st;
    if (threadIdx.x == 0) (void)xb_add(&bar[XB_XCNT(b.x)], 1u);
    return b;
}
DI void xcd_barrier_complete(unsigned* bar, unsigned x, unsigned& nloc, unsigned& nx) {
    const unsigned G = gridDim.x * gridDim.y * gridDim.z;
    unsigned sum, cnt, mine, sp = 0u;
    for (;;) {
        sum = 0u; cnt = 0u; mine = 0u;
#pragma unroll
        for (unsigned j = 0; j < 16; ++j) { const unsigned c = xb_ld(&bar[XB_XCNT(j)]); sum += c; cnt += (c > 0u) ? 1u : 0u; mine = (j == x) ? c : mine; }
        if (sum == G) break;
        if ((++sp & 255u) == 0u) { if (xb_ld(&bar[XB_TMO])) break; if (sp > XB_SPIN_CAP) { atomicAdd(&bar[XB_TMO], 1u); break; } }
    }
    nloc = mine > 0u ? mine : 1u; nx = cnt > 0u ? cnt : 1u;
}
DI void xcd_barrier(const XcdBarrier& b) {
    asm volatile("s_waitcnt vmcnt(0)" ::: "memory");
    __syncthreads();
    if (threadIdx.x == 0) {
        unsigned* bar = b.bar;
        __builtin_amdgcn_s_waitcnt(0);
        unsigned nloc = b.st[0], nx = b.st[1];
        if (nloc == 0u) { xcd_barrier_complete(bar, b.x, nloc, nx); b.st[0] = nloc; b.st[1] = nx; }
        const unsigned old = xb_add(&bar[XB_XSUB(b.x)], 1u);
        const unsigned gen = old / nloc;
        if (old + 1u == (gen + 1u) * nloc) {
            __builtin_amdgcn_fence(__ATOMIC_RELEASE, "agent");
            asm volatile("s_waitcnt vmcnt(0)" ::: "memory");
            const unsigned og = xb_add(&bar[XB_TOP], 1u);
            const unsigned tg = og / nx;
            if (og + 1u == (tg + 1u) * nx) xb_add(&bar[XB_TOPGEN], 1u);
            else XB_SPIN(xb_ld(&bar[XB_TOPGEN]) == tg, bar);
            __builtin_amdgcn_fence(__ATOMIC_ACQUIRE, "agent");
            xb_add(&bar[XB_XGEN(b.x)], 1u);
            asm volatile("s_waitcnt vmcnt(0)" ::: "memory");
        } else {
            XB_SPIN(xb_ld(&bar[XB_XGEN(b.x)]) == gen, bar);
            __builtin_amdgcn_fence(__ATOMIC_ACQUIRE, "agent");
            asm volatile("s_waitcnt vmcnt(0)" ::: "memory");
        }
    }
    __syncthreads();
}

struct Params {
    const float* in[19]; float* out; unsigned char* ws;
};

DI void tr_item(const float* src, int ldsrc, int col0, bf16_t* dst, int K, int row0, const float* scale, int ncb, LAS float* scr, int item, int lane) {
    const int kb = item / ncb, nb = item % ncb, k0 = 64 * kb, n0 = 32 * nb;
#pragma unroll
    for (int i = 0; i < 32; ++i) { const int kk = 2 * i + (lane >> 5); float v = src[(size_t)(k0 + kk) * ldsrc + col0 + n0 + (lane & 31)]; if (scale) v *= scale[k0 + kk]; scr[kk * 33 + (lane & 31)] = v; }
    asm volatile("s_waitcnt lgkmcnt(0)" ::: "memory");
    const int c = lane & 7;
#pragma unroll
    for (int j = 0; j < 4; ++j) { const int n = (lane >> 3) + 8 * j; const LAS float* s = scr + (8 * c) * 33 + n;
        u32x4 o; o.x = pk2(s[0 * 33], s[1 * 33]); o.y = pk2(s[2 * 33], s[3 * 33]); o.z = pk2(s[4 * 33], s[5 * 33]); o.w = pk2(s[6 * 33], s[7 * 33]);
        *(u32x4*)(dst + (size_t)(row0 + n0 + n) * K + k0 + 8 * c) = o; }
    asm volatile("s_waitcnt lgkmcnt(0)" ::: "memory");
}
DI void convert_weights(const Params& p, int l, LAS unsigned char* lds, int it0, int it1, bool tail, int gw0, int ngw) {
    const int tid_ = otid(), lane = tid_ & 63, wave = __builtin_amdgcn_readfirstlane(tid_ >> 6), gw = gw0 + wave;
    LAS float* scr = (LAS float*)(lds + wave * 8704);
    unsigned char* W = p.ws + WS_W;
    const float* w_in = p.in[6] + (size_t)l * D * INW; const float* g1 = p.in[5] + l * D; const float* g2 = p.in[15] + l * D;
    constexpr int I0 = 16 * 112, I1 = 16 * 32, I2 = 16 * 32, I3 = 8 * 32, I4 = 8 * 32, I5 = 16 * 32, I6 = 16 * 128, I7 = 64 * 32;
    constexpr int NIT = I0 + I1 + I2 + I3 + I4 + I5 + I6 + I7;
    for (int it = it0 + gw; it < it1; it += ngw) {
        int r = it;
        if (r < I0) { tr_item(w_in, INW, 0, (bf16_t*)(W + W_IN), D, 0, g1, 112, scr, r, lane); continue; } r -= I0;
        if (r < I1) { tr_item(w_in, INW, 3592, (bf16_t*)(W + W_IN), D, R_GA, g1, 32, scr, r, lane); continue; } r -= I1;
        if (r < I2) { tr_item(w_in, INW, 4616, (bf16_t*)(W + W_IN), D, R_GB, g1, 32, scr, r, lane); continue; } r -= I2;
        if (r < I3) { tr_item(p.in[8] + (size_t)l * 512 * D, D, 0, (bf16_t*)(W + W_A), 512, 0, nullptr, 32, scr, r, lane); continue; } r -= I3;
        if (r < I4) { tr_item(p.in[13] + (size_t)l * 512 * D, D, 0, (bf16_t*)(W + W_B), 512, 0, nullptr, 32, scr, r, lane); continue; } r -= I4;
        if (r < I5) { tr_item(p.in[14] + (size_t)l * D * D, D, 0, (bf16_t*)(W + W_O), D, 0, nullptr, 32, scr, r, lane); continue; } r -= I5;
        if (r < I6) { tr_item(p.in[16] + (size_t)l * D * FF, FF, 0, (bf16_t*)(W + W_UP), D, 0, g2, 128, scr, r, lane); continue; } r -= I6;
        tr_item(p.in[17] + (size_t)l * FF * D, D, 0, (bf16_t*)(W + W_DN), FF, 0, nullptr, 32, scr, r, lane);
    }
    bf16_t* wi = (bf16_t*)(W + W_IN);
    if (tail)
    for (int e = gw * 64 + lane; e < 256 * D; e += ngw * 64) { const int n = e >> 10, k = e & 1023; float v = 0.f; if (n < 8) v = w_in[(size_t)k * INW + 3584 + n] * g1[k]; wi[(size_t)(3584 + n) * D + k] = (bf16_t)f2bf(v); }
}

DI void mixer_a_phase(const Params& p, int l) {
    const int gtid = blockIdx.x * 512 + otid(), gthreads = gridDim.x * 512;
    bf16_t* P = (bf16_t*)(p.ws + WS_P);
    const float* cw = p.in[7] + (size_t)l * 3 * 512;
    const float* sca = p.in[2] + (size_t)l * DB * 2 * 512;
    for (int it = gtid; it < T * 64; it += gthreads) {
        const int r = it >> 6, c0 = (it & 63) * 8;
        int t, b; bool smp = r >= TP; if (!smp) { b = r >> 13; t = r & 8191; } else { b = (r - TP) >> 4; t = (r - TP) & 15; }
        float cx[3][8];
#pragma unroll
        for (int j = 0; j < 3; ++j) { const int tt = t - 2 + j;
            if (tt >= 0) { const u32x4 ca = *(const u32x4*)(P + (size_t)(r - 2 + j) * LDP + C_CA + c0); const u32x4 xa = *(const u32x4*)(P + (size_t)(r - 2 + j) * LDP + C_XA + c0);
                cx[j][0] = bflo(ca.x) * bflo(xa.x); cx[j][1] = bfhi(ca.x) * bfhi(xa.x); cx[j][2] = bflo(ca.y) * bflo(xa.y); cx[j][3] = bfhi(ca.y) * bfhi(xa.y);
                cx[j][4] = bflo(ca.z) * bflo(xa.z); cx[j][5] = bfhi(ca.z) * bfhi(xa.z); cx[j][6] = bflo(ca.w) * bflo(xa.w); cx[j][7] = bfhi(ca.w) * bfhi(xa.w); }
            else if (smp) { const float* s = sca + ((size_t)b * 2 + (2 + tt)) * 512 + c0;
#pragma unroll
                for (int e = 0; e < 8; ++e) cx[j][e] = s[e]; }
            else {
#pragma unroll
                for (int e = 0; e < 8; ++e) cx[j][e] = 0.f; } }
        const u32x4 ba = *(const u32x4*)(P + (size_t)r * LDP + C_BA + c0);
        float bv[8] = {bflo(ba.x), bfhi(ba.x), bflo(ba.y), bfhi(ba.y), bflo(ba.z), bfhi(ba.z), bflo(ba.w), bfhi(ba.w)};
        float o[8];
#pragma unroll
        for (int e = 0; e < 8; ++e) { const float u = cx[0][e] * cw[c0 + e] + cx[1][e] * cw[512 + c0 + e] + cx[2][e] * cw[1024 + c0 + e]; o[e] = bv[e] * u; }
        u32x4 w; w.x = pk2(o[0], o[1]); w.y = pk2(o[2], o[3]); w.z = pk2(o[4], o[5]); w.w = pk2(o[6], o[7]);
        *(u32x4*)(P + (size_t)r * LDP + C_BA + c0) = w;
        {
            const u32x4 zq = *(const u32x4*)(P + (size_t)r * LDP + C_Z + c0);
            float zv[8] = {bflo(zq.x), bfhi(zq.x), bflo(zq.y), bfhi(zq.y), bflo(zq.z), bfhi(zq.z), bflo(zq.w), bfhi(zq.w)};
#pragma unroll
            for (int e = 0; e < 8; ++e) zv[e] = zv[e] * sigm(zv[e]);
            u32x4 zw; zw.x = pk2(zv[0], zv[1]); zw.y = pk2(zv[2], zv[3]); zw.z = pk2(zv[4], zv[5]); zw.w = pk2(zv[6], zv[7]);
            *(u32x4*)(P + (size_t)r * LDP + C_Z + c0) = zw; }
        const int L = smp ? DSEQ : SEQ;
        if (t >= L - 2) { float* dst = smp ? p.out + O_SA + (((size_t)l * DB + b) * 2 + (t - (L - 2))) * 512 + c0 : p.out + O_PA + (((size_t)l * 2 + b) * 2 + (t - (L - 2))) * 512 + c0;
#pragma unroll
            for (int e = 0; e < 8; ++e) dst[e] = cx[2][e]; }
    }
    for (int it = gtid; it < (2 + DB) * 3 * 1536; it += gthreads) {
        const int c = it % 1536, j = (it / 1536) % 3, sb = it / (3 * 1536);
        if (sb < 2) { const int r = sb * SEQ + SEQ - 3 + j; p.out[O_PQ + (((size_t)l * 2 + sb) * 3 + j) * 1536 + c] = bf2f(P[(size_t)r * LDP + C_QKV + c]); }
        else { const int b = sb - 2, r = TP + b * DSEQ + DSEQ - 3 + j; p.out[O_SQ + (((size_t)l * DB + b) * 3 + j) * 1536 + c] = bf2f(P[(size_t)r * LDP + C_QKV + c]); }
    }
}

constexpr int L_SCR = 0, L_QB = 33792, L_KB = 51200, L_VB = 68608, L_AM = 86016, L_GC = 103424, L_BE = 103680, L_RN = 103936, L_EG = 104192, L_SOL = 104448;
DI void chunk_item(const Params& p, int l, bool smp, int chain, int n, unsigned char* item, LAS unsigned char* lds) {
    const int tid = otid(), lane = tid & 63, wave = tid >> 6;
    const bf16_t* P = (const bf16_t*)(p.ws + WS_P); const float* BG = (const float*)(p.ws + WS_BG);
    const int h = chain & 3, bb = chain >> 2;
    const int r0 = smp ? TP + bb * DSEQ : bb * SEQ + n * 64;
    const int nvalid = smp ? DSEQ : 64;
    const bool hist_proj = (!smp) && n > 0;
    LAS float* SCR = (LAS float*)(lds + L_SCR); LAS bf16_t* QB = (LAS bf16_t*)(lds + L_QB); LAS bf16_t* KB = (LAS bf16_t*)(lds + L_KB); LAS bf16_t* VB = (LAS bf16_t*)(lds + L_VB);
    LAS float* AM = (LAS float*)(lds + L_AM); LAS float* GC = (LAS float*)(lds + L_GC); LAS float* BE = (LAS float*)(lds + L_BE); LAS float* RN = (LAS float*)(lds + L_RN); LAS float* EG = (LAS float*)(lds + L_EG);
    const int col = tid & 127, rq = tid >> 7;
    const float* cqw = p.in[9] + (size_t)l * 4 * 1536;
    const float* scq = p.in[3] + ((size_t)l * DB + bb) * 3 * 1536;
    if (wave == 0) {
        const int i = lane; const bool valid = i < nvalid;
        float be = 0.f, g = 0.f;
        if (valid) { const float br = BG[(size_t)(r0 + i) * 8 + h], ar = BG[(size_t)(r0 + i) * 8 + 4 + h];
            be = sigm(br); const float xx = ar + p.in[11][l * 4 + h]; const float sp = xx > 20.f ? xx : log1pf(__expf(xx)); g = -__expf(p.in[10][l * 4 + h]) * sp; }
        float gc = g;
#pragma unroll
        for (int off = 1; off < 64; off <<= 1) { const float tv = __shfl_up(gc, off); if (lane >= off) gc += tv; }
        GC[i] = gc; BE[i] = be; EG[i] = __expf(gc);
        if (lane == 63) *(float*)(item + IT_GL) = __expf(gc);
    }
#pragma unroll 1
    for (int part = 0; part < 3; ++part) {
        const int pc = part * 512 + h * 128 + col;
        const float w0 = cqw[pc], w1 = cqw[1536 + pc], w2 = cqw[2 * 1536 + pc], w3 = cqw[3 * 1536 + pc];
        float x0, x1, x2;
        {
            const int i0 = rq * 16;
            float hv[3];
#pragma unroll
            for (int j = 0; j < 3; ++j) { const int i = i0 - 3 + j; float v = 0.f;
                if (i >= 0) { if (i < nvalid) v = bf2f(P[(size_t)(r0 + i) * LDP + C_QKV + pc]); }
                else if (hist_proj) v = bf2f(P[(size_t)(r0 + i) * LDP + C_QKV + pc]);
                else if (smp) v = scq[(size_t)(3 + i) * 1536 + pc];
                hv[j] = v; }
            x0 = hv[0]; x1 = hv[1]; x2 = hv[2];
        }
#pragma unroll
        for (int ii = 0; ii < 16; ++ii) { const int i = rq * 16 + ii; float x3 = 0.f; if (i < nvalid) x3 = bf2f(P[(size_t)(r0 + i) * LDP + C_QKV + pc]);
            const float y = w0 * x0 + w1 * x1 + w2 * x2 + w3 * x3; float s = y * sigm(y); if (i >= nvalid) s = 0.f;
            SCR[i * 132 + col] = s; x0 = x1; x1 = x2; x2 = x3; }
        lds_barrier();
        if (part < 2) {
            const int row = tid >> 3, pt = tid & 7; float ssum = 0.f;
#pragma unroll
            for (int e = 0; e < 16; ++e) { const float v = SCR[row * 132 + pt * 16 + e]; ssum += v * v; }
            ssum += __shfl_xor(ssum, 1); ssum += __shfl_xor(ssum, 2); ssum += __shfl_xor(ssum, 4);
            if (pt == 0) RN[row] = rsqrtf(ssum + EPS) * (part == 0 ? 0.08838834764831845f : 1.0f);
            lds_barrier();
        }
        LAS bf16_t* dst = part == 0 ? QB : (part == 1 ? KB : VB);
#pragma unroll
        for (int ii = 0; ii < 16; ++ii) { const int i = rq * 16 + ii; float v = SCR[i * 132 + col]; if (part < 2) v *= RN[i]; dst[i * 136 + col] = (bf16_t)f2bf(v); }
        lds_barrier();
    }
    {
        bf16_t* PPg = (bf16_t*)(item + IT_PP);
#pragma unroll 1
        for (int jj = 0; jj < 4; ++jj) { const int job = wave * 4 + jj, which = job >> 4, ti = (job & 15) >> 2, tj = job & 3;
            f32x4 acc = {0.f, 0.f, 0.f, 0.f};
            if (tj <= ti) {
                const LAS bf16_t* Asrc = which ? QB : KB;
#pragma unroll
                for (int kk = 0; kk < 4; ++kk) { const bf16x8 a = *(const LAS bf16x8*)(Asrc + (16 * ti + (lane & 15)) * 136 + 32 * kk + 8 * (lane >> 4));
                    const bf16x8 b = *(const LAS bf16x8*)(KB + (16 * tj + (lane & 15)) * 136 + 32 * kk + 8 * (lane >> 4));
                    acc = __builtin_amdgcn_mfma_f32_16x16x32_bf16(a, b, acc, 0, 0, 0); }
            }
            const int j = 16 * tj + (lane & 15);
#pragma unroll
            for (int e = 0; e < 4; ++e) { const int i = 16 * ti + 4 * (lane >> 4) + e;
                const float dec = (j <= i) ? __expf(GC[i] - GC[j]) : 0.f;
                if (which == 0) AM[j * 68 + i] = (j < i) ? acc[e] * dec * BE[i] : 0.f;
                else PPg[i * 64 + perm16(j)] = (bf16_t)f2bf(acc[e] * dec); }
        }
    }
    lds_barrier();
    if (tid < 256) {
        const int c = tid; LAS float* SOL = (LAS float*)(lds + L_SOL);
        bf16_t* WV = (bf16_t*)(item + IT_WV); bf16_t* WK = (bf16_t*)(item + IT_WK);
#pragma unroll 1
        for (int rb = 0; rb < 4; ++rb) {
            float s[16];
#pragma unroll
            for (int ii = 0; ii < 16; ++ii) { const int i = 16 * rb + ii; s[ii] = (c < 128) ? bf2f(VB[i * 136 + c]) * BE[i] : bf2f(KB[i * 136 + (c - 128)]) * BE[i] * EG[i]; }
#pragma unroll 2
            for (int j = 0; j < 16 * rb; ++j) { const float x = SOL[j * 256 + c];
#pragma unroll
                for (int q4 = 0; q4 < 4; ++q4) { const f32x4 a = *(const LAS f32x4*)(AM + j * 68 + 16 * rb + 4 * q4);
#pragma unroll
                    for (int e = 0; e < 4; ++e) s[4 * q4 + e] -= a[e] * x; } }
#pragma unroll
            for (int jj = 0; jj < 15; ++jj) {
#pragma unroll
                for (int q4 = 0; q4 < 4; ++q4) { if (4 * q4 + 3 > jj) { const f32x4 a = *(const LAS f32x4*)(AM + (16 * rb + jj) * 68 + 16 * rb + 4 * q4);
#pragma unroll
                    for (int e = 0; e < 4; ++e) if (4 * q4 + e > jj) s[4 * q4 + e] -= a[e] * s[jj]; } } }
            if (rb < 3) {
#pragma unroll
                for (int ii = 0; ii < 16; ++ii) SOL[(16 * rb + ii) * 256 + c] = s[ii]; }
            if (c < 128) { const int w = c >> 5, cc = c & 31;
#pragma unroll
                for (int ii = 0; ii < 16; ++ii) { const int i = 16 * rb + ii; const int mt = i >> 5, i5 = i & 31, hi = (i5 >> 2) & 1, idx = 4 * (i5 >> 3) + (i5 & 3);
                    WV[((w * 2 + mt) * 64 + cc + 32 * hi) * 16 + idx] = (bf16_t)f2bf(s[ii]); } }
            else { const int k = perm16(c - 128);
#pragma unroll
                for (int ii = 0; ii < 16; ++ii) WK[(16 * rb + ii) * 128 + k] = (bf16_t)f2bf(-s[ii]); }
        }
    } else {
        const int t2 = tid - 256; bf16_t* QG = (bf16_t*)(item + IT_QG); bf16_t* KT = (bf16_t*)(item + IT_KT); const float gce = GC[63];
#pragma unroll 4
        for (int it = 0; it < 32; ++it) { const int e = t2 + 256 * it; const int i = e >> 7, k = e & 127; QG[i * 128 + perm16(k)] = (bf16_t)f2bf(bf2f(QB[i * 136 + k]) * EG[i]); }
#pragma unroll 4
        for (int it = 0; it < 32; ++it) { const int e = t2 + 256 * it; const int k = e >> 6, c = e & 63; KT[k * 64 + perm16(c)] = (bf16_t)f2bf(bf2f(KB[c * 136 + k]) * __expf(gce - GC[c])); }
    }
    lds_barrier();
}

constexpr int B_WK = 0, B_QG = 17408, B_KT = 34816, B_PP = 53248, B_SZ = 62464, L_STG = 2 * B_SZ, STG_P = 68, STG_SZ = 128 * STG_P * 2;
DI bf16x8 pack8(const f32x16& v, int o) {
    u32x4 w; w.x = pk2(v[o + 0], v[o + 1]); w.y = pk2(v[o + 2], v[o + 3]); w.z = pk2(v[o + 4], v[o + 5]); w.w = pk2(v[o + 6], v[o + 7]);
    return __builtin_bit_cast(bf16x8, w);
}
DI void onorm_pass(const Params& p, int l, LAS unsigned char* lds, int tp0, int tp1, int stride) {
    const int tid = otid();
    bf16_t* P = (bf16_t*)(p.ws + WS_P); const float* og = p.in[12] + l * 128;
    LAS bf16_t* tl = (LAS bf16_t*)lds;
    const int half = tid >> 8, t2 = tid & 255, row = t2 >> 2, q = t2 & 3;
    LAS bf16_t* mine = tl + half * (128 * STG_P);
    for (int tp = tp0; tp < tp1; tp += stride) {
        const int tile = tp * 2 + half;
        const unsigned char* src = (const unsigned char*)p.out + OUT_OT + (size_t)tile * 16384;
        u32x4 ldv[4];
#pragma unroll
        for (int k = 0; k < 4; ++k) ldv[k] = *(const u32x4*)(src + (t2 + 256 * k) * 16);
#pragma unroll
        for (int k = 0; k < 4; ++k) { const int j = t2 + 256 * k; LAS u32x2* d2 = (LAS u32x2*)((LAS unsigned char*)mine + (j >> 3) * (STG_P * 2) + (j & 7) * 16);
            d2[0] = (u32x2){ldv[k].x, ldv[k].y}; d2[1] = (u32x2){ldv[k].z, ldv[k].w}; }
        lds_barrier();
        const bool smp = tile >= 1024; int r, h; bool rvalid;
        if (!smp) { const int chain = tile >> 7, n = tile & 127; h = chain & 3; r = (chain >> 2) * SEQ + n * 64 + row; rvalid = true; }
        else { const int c = tile - 1024; h = c & 3; r = TP + (c >> 2) * DSEQ + row; rvalid = row < DSEQ; }
        float v[32]; float ssum = 0.f;
#pragma unroll
        for (int e = 0; e < 32; ++e) { v[e] = bf2f(mine[((e >> 3) * 32 + q * 8 + (e & 7)) * STG_P + row]); ssum += v[e] * v[e]; }
        ssum += __shfl_xor(ssum, 1); ssum += __shfl_xor(ssum, 2);
        const float rs = rsqrtf(ssum * (1.0f / 128.0f) + EPS);
        if (rvalid) { bf16_t* zp = P + (size_t)r * LDP + C_Z + h * 128 + q * 8;
#pragma unroll
            for (int e = 0; e < 4; ++e) { const u32x4 z = *(const u32x4*)(zp + e * 32); const float zz[8] = {bflo(z.x), bfhi(z.x), bflo(z.y), bfhi(z.y), bflo(z.z), bfhi(z.z), bflo(z.w), bfhi(z.w)}; float o[8];
#pragma unroll
                for (int k = 0; k < 8; ++k) o[k] = v[8 * e + k] * rs * og[e * 32 + q * 8 + k] * zz[k];
                u32x4 w; w.x = pk2(o[0], o[1]); w.y = pk2(o[2], o[3]); w.z = pk2(o[4], o[5]); w.w = pk2(o[6], o[7]); *(u32x4*)(zp + e * 32) = w; } }
        lds_barrier();
    }
}
DI void scan_chain(const Params& p, int l, bool smp, int chain, int n0, int nsteps, const unsigned char* items, bool first_seg, bool last_seg, LAS unsigned char* lds, bool dry) {
    const int tid = otid(), lane = tid & 63, wave = __builtin_amdgcn_readfirstlane(tid >> 6);
    const int h = chain & 3, bb = chain >> 2;
    const int nvalid = smp ? DSEQ : 64;
    bf16_t* P = (bf16_t*)(p.ws + WS_P);
    if (wave < 4) {
        const int cl = lane & 31, hi = lane >> 5, vcol = wave * 32 + cl;
        f32x16 S[4];
        float* sbuf = (float*)(p.ws + WS_SB) + (size_t)chain * 16384;
        if (smp) { const float* s0 = p.in[4] + (((size_t)l * DB + bb) * 4 + h) * 16384;
#pragma unroll
            for (int t = 0; t < 4; ++t)
#pragma unroll
                for (int i = 0; i < 16; ++i) S[t][i] = s0[(32 * t + 8 * (i >> 2) + 4 * hi + (i & 3)) * 128 + vcol]; }
        else if (first_seg) {
#pragma unroll
            for (int t = 0; t < 4; ++t)
#pragma unroll
                for (int i = 0; i < 16; ++i) S[t][i] = 0.f; }
        else {
#pragma unroll
            for (int t = 0; t < 4; ++t)
#pragma unroll
                for (int i = 0; i < 16; ++i) S[t][i] = sbuf[((wave * 4 + t) * 16 + i) * 64 + lane]; }
        u32x4 wvA[4], wvB[4]; float glA = 1.f, glB = 1.f;
        { const u32x4* wv = (const u32x4*)(items + IT_WV) + ((wave * 2) * 64 + lane) * 2;
            wvA[0] = wv[0]; wvA[1] = wv[1]; wvA[2] = wv[128]; wvA[3] = wv[129]; glA = *(const float*)(items + IT_GL); }
#pragma unroll
        for (int e = 0; e < 4; ++e) wvB[e] = (u32x4){0u, 0u, 0u, 0u};
        if (nsteps > 1) { const unsigned char* itp = items + ITEM_BYTES; const u32x4* wv = (const u32x4*)(itp + IT_WV) + ((wave * 2) * 64 + lane) * 2;
            wvB[0] = wv[0]; wvB[1] = wv[1]; wvB[2] = wv[128]; wvB[3] = wv[129]; glB = *(const float*)(itp + IT_GL); }
        lds_barrier();
#pragma unroll 1
        for (int s = 0; s < nsteps; ++s) {
            const LAS unsigned char* B = lds + (s & 1) * B_SZ;
            f32x16 U[2], O[2]; float gl;
#define SC_UNPACK(WV) do { _Pragma("unroll") for (int mt = 0; mt < 2; ++mt) { const u32x4 a = WV[2 * mt], b = WV[2 * mt + 1]; \
                U[mt][0] = bflo(a.x); U[mt][1] = bfhi(a.x); U[mt][2] = bflo(a.y); U[mt][3] = bfhi(a.y); U[mt][4] = bflo(a.z); U[mt][5] = bfhi(a.z); U[mt][6] = bflo(a.w); U[mt][7] = bfhi(a.w); \
                U[mt][8] = bflo(b.x); U[mt][9] = bfhi(b.x); U[mt][10] = bflo(b.y); U[mt][11] = bfhi(b.y); U[mt][12] = bflo(b.z); U[mt][13] = bfhi(b.z); U[mt][14] = bflo(b.w); U[mt][15] = bfhi(b.w); } } while (0)
#define SC_WVLOAD(WV, GL) do { const unsigned char* itp = items + (size_t)(s + 2) * ITEM_BYTES; const u32x4* wv = (const u32x4*)(itp + IT_WV) + ((wave * 2) * 64 + lane) * 2; \
                WV[0] = wv[0]; WV[1] = wv[1]; WV[2] = wv[128]; WV[3] = wv[129]; GL = *(const float*)(itp + IT_GL); } while (0)
            if (s & 1) { SC_UNPACK(wvB); gl = glB; if (s + 2 < nsteps) SC_WVLOAD(wvB, glB); }
            else { SC_UNPACK(wvA); gl = glA; if (s + 2 < nsteps) SC_WVLOAD(wvA, glA); }
#pragma unroll
            for (int mt = 0; mt < 2; ++mt)
#pragma unroll
                for (int i = 0; i < 16; ++i) O[mt][i] = 0.f;
            bf16x8 A0[6], A1[6];
#define SC_SB() __builtin_amdgcn_sched_barrier(0)
#define SC_LD1(dst, blk) do { const int ko_ = (16 * (blk) + 8 * hi) * 2; \
                dst[0] = *(const LAS bf16x8*)(B + B_WK + cl * 272 + ko_); dst[1] = *(const LAS bf16x8*)(B + B_WK + (32 + cl) * 272 + ko_); \
                dst[2] = *(const LAS bf16x8*)(B + B_QG + cl * 272 + ko_); dst[3] = *(const LAS bf16x8*)(B + B_QG + (32 + cl) * 272 + ko_); } while (0)
#define SC_LD2(dst, blk) do { const int ko_ = (16 * (blk) + 8 * hi) * 2; \
                dst[0] = *(const LAS bf16x8*)(B + B_KT + cl * 144 + ko_); dst[1] = *(const LAS bf16x8*)(B + B_KT + (32 + cl) * 144 + ko_); \
                dst[2] = *(const LAS bf16x8*)(B + B_KT + (64 + cl) * 144 + ko_); dst[3] = *(const LAS bf16x8*)(B + B_KT + (96 + cl) * 144 + ko_); \
                dst[4] = *(const LAS bf16x8*)(B + B_PP + cl * 144 + ko_); dst[5] = *(const LAS bf16x8*)(B + B_PP + (32 + cl) * 144 + ko_); } while (0)
#define SC_MM1(src, blk) do { const bf16x8 Sbk = pack8(S[(blk) >> 1], ((blk) & 1) * 8); \
                U[0] = __builtin_amdgcn_mfma_f32_32x32x16_bf16(src[0], Sbk, U[0], 0, 0, 0); O[0] = __builtin_amdgcn_mfma_f32_32x32x16_bf16(src[2], Sbk, O[0], 0, 0, 0); \
                U[1] = __builtin_amdgcn_mfma_f32_32x32x16_bf16(src[1], Sbk, U[1], 0, 0, 0); O[1] = __builtin_amdgcn_mfma_f32_32x32x16_bf16(src[3], Sbk, O[1], 0, 0, 0); } while (0)
#define SC_MM2(src, blk) do { const bf16x8 Ubk = pack8(U[(blk) >> 1], ((blk) & 1) * 8); \
                S[0] = __builtin_amdgcn_mfma_f32_32x32x16_bf16(src[0], Ubk, S[0], 0, 0, 0); S[1] = __builtin_amdgcn_mfma_f32_32x32x16_bf16(src[1], Ubk, S[1], 0, 0, 0); \
                S[2] = __builtin_amdgcn_mfma_f32_32x32x16_bf16(src[2], Ubk, S[2], 0, 0, 0); S[3] = __builtin_amdgcn_mfma_f32_32x32x16_bf16(src[3], Ubk, S[3], 0, 0, 0); \
                O[0] = __builtin_amdgcn_mfma_f32_32x32x16_bf16(src[4], Ubk, O[0], 0, 0, 0); O[1] = __builtin_amdgcn_mfma_f32_32x32x16_bf16(src[5], Ubk, O[1], 0, 0, 0); } while (0)
            SC_LD1(A0, 0); SC_SB();
            SC_LD1(A1, 1); SC_SB(); SC_MM1(A0, 0); SC_SB();
            SC_LD1(A0, 2); SC_SB(); SC_MM1(A1, 1); SC_SB();
            SC_LD1(A1, 3); SC_SB(); SC_MM1(A0, 2); SC_SB();
            SC_LD1(A0, 4); SC_SB(); SC_MM1(A1, 3); SC_SB();
            SC_LD1(A1, 5); SC_SB(); SC_MM1(A0, 4); SC_SB();
            SC_LD1(A0, 6); SC_SB(); SC_MM1(A1, 5); SC_SB();
            SC_LD1(A1, 7); SC_SB(); SC_MM1(A0, 6); SC_SB();
            SC_LD2(A0, 0); SC_SB(); SC_MM1(A1, 7); SC_SB();
#pragma unroll
            for (int t = 0; t < 4; ++t) S[t] = S[t] * gl;
            SC_SB();
            SC_LD2(A1, 1); SC_SB(); SC_MM2(A0, 0); SC_SB();
            SC_LD2(A0, 2); SC_SB(); SC_MM2(A1, 1); SC_SB();
            SC_LD2(A1, 3); SC_SB(); SC_MM2(A0, 2); SC_SB();
            SC_MM2(A1, 3); SC_SB();
            LAS bf16_t* stg = (LAS bf16_t*)(lds + L_STG + (s & 1) * STG_SZ);
#pragma unroll
            for (int mt = 0; mt < 2; ++mt)
#pragma unroll
                for (int a4 = 0; a4 < 4; ++a4) { u32x2 w; w.x = pk2(O[mt][4 * a4 + 0], O[mt][4 * a4 + 1]); w.y = pk2(O[mt][4 * a4 + 2], O[mt][4 * a4 + 3]);
                    *(LAS u32x2*)(stg + vcol * STG_P + 32 * mt + 8 * a4 + 4 * hi) = w; }
            lds_barrier();
        }
        lds_barrier();
        int vcol2 = vcol, hi2 = hi, lane2 = lane; asm volatile("" : "+v"(vcol2), "+v"(hi2), "+v"(lane2));
        if (dry) {} else if (smp || last_seg) { float* so = smp ? p.out + O_SS + (((size_t)l * DB + bb) * 4 + h) * 16384 : p.out + O_PS + (((size_t)l * 2 + bb) * 4 + h) * 16384;
#pragma unroll
            for (int t = 0; t < 4; ++t)
#pragma unroll
                for (int i = 0; i < 16; ++i) so[(32 * t + 8 * (i >> 2) + 4 * hi2 + (i & 3)) * 128 + vcol2] = S[t][i]; }
        else {
#pragma unroll
            for (int t = 0; t < 4; ++t)
#pragma unroll
                for (int i = 0; i < 16; ++i) sbuf[((wave * 4 + t) * 16 + i) * 64 + lane2] = S[t][i]; }
    } else {
        const int t2 = tid - 256;
        u32x4 ld[14];
#define SC_ISSUE(s_) do { const u32x4* src_ = (const u32x4*)(items + (size_t)(s_) * ITEM_BYTES); _Pragma("unroll") for (int it = 0; it < 14; ++it) ld[it] = src_[t2 + 256 * it]; } while (0)
#define SC_COMMIT(s_) do { LAS unsigned char* B_ = lds + ((s_) & 1) * B_SZ; _Pragma("unroll") for (int it = 0; it < 14; ++it) *(LAS u32x4*)(B_ + dsto[it]) = ld[it]; } while (0)
        unsigned char* otile0 = (unsigned char*)p.out + OUT_OT + (size_t)(smp ? 1024 + chain : chain * 128 + n0) * 16384;
        int dsto[14];
#pragma unroll
        for (int it = 0; it < 14; ++it) { const int off = (t2 + 256 * it) * 16; int dst;
            if (off < 32768) { const int o2 = off & 16383; dst = (off < 16384 ? B_WK : B_QG) + (o2 >> 8) * 272 + (o2 & 255); }
            else if (off < 49152) { const int o2 = off - 32768; dst = B_KT + (o2 >> 7) * 144 + (o2 & 127); }
            else { const int o2 = off - 49152; dst = B_PP + (o2 >> 7) * 144 + (o2 & 127); }
            dsto[it] = dst; }
#define SC_OCOPY(sp_) do { if (!dry) { const LAS unsigned char* stg_ = lds + L_STG + ((sp_) & 1) * STG_SZ; unsigned char* ot_ = otile0 + (size_t)(sp_) * 16384; \
            _Pragma("unroll") for (int k = 0; k < 4; ++k) { const int j = t2 + 256 * k; const LAS u32x2* sp2 = (const LAS u32x2*)(stg_ + (j >> 3) * (STG_P * 2) + (j & 7) * 16); \
                const u32x2 lo = sp2[0], hi2 = sp2[1]; *(u32x4*)(ot_ + j * 16) = (u32x4){lo.x, lo.y, hi2.x, hi2.y}; } } } while (0)
        u32x4 ldB[14];
#define SC_ISSUE2(LD, s_) do { const u32x4* src_ = (const u32x4*)(items + (size_t)(s_) * ITEM_BYTES); _Pragma("unroll") for (int it = 0; it < 14; ++it) LD[it] = src_[t2 + 256 * it]; } while (0)
#define SC_COMMIT2(LD, s_) do { LAS unsigned char* B_ = lds + ((s_) & 1) * B_SZ; _Pragma("unroll") for (int it = 0; it < 14; ++it) *(LAS u32x4*)(B_ + dsto[it]) = LD[it]; } while (0)
        SC_ISSUE2(ld, 0); SC_COMMIT2(ld, 0);
        if (nsteps > 1) SC_ISSUE2(ld, 1);
        if (nsteps > 2) SC_ISSUE2(ldB, 2);
        lds_barrier();
#pragma unroll 1
        for (int s = 0; s < nsteps; s += 2) {
            if (s + 1 < nsteps) SC_COMMIT2(ld, s + 1);
            if (s + 3 < nsteps) SC_ISSUE2(ld, s + 3);
            if (s > 0) SC_OCOPY(s - 1);
            lds_barrier();
            if (s + 1 >= nsteps) break;
            if (s + 2 < nsteps) SC_COMMIT2(ldB, s + 2);
            if (s + 4 < nsteps) SC_ISSUE2(ldB, s + 4);
            SC_OCOPY(s);
            lds_barrier();
        }
        SC_OCOPY(nsteps - 1);
        lds_barrier();
    }
}

DI void sample_fix(const Params& p, ssq_t* ss) {
    const int tid_ = otid(), lane = tid_ & 63, gw = blockIdx.x * 8 + __builtin_amdgcn_readfirstlane(tid_ >> 6), ngw = gridDim.x * 8;
    const float* part = (const float*)(p.ws + WS_PART); bf16_t* AB = (bf16_t*)(p.ws + WS_AB);
    for (int rr = gw; rr < TS; rr += ngw) { const int r = TP + rr; u32x2* xb2 = (u32x2*)(AB + (size_t)r * D); float s = 0.f;
#pragma unroll
        for (int j = 0; j < 4; ++j) { const u32x2 w0 = xb2[lane + 64 * j]; f32x4 v = {bflo(w0.x), bfhi(w0.x), bflo(w0.y), bfhi(w0.y)};
#pragma unroll
            for (int k = 0; k < 8; ++k) v += *((const f32x4*)(part + ((size_t)k * TS + rr) * D) + lane + 64 * j);
            s += (v[0] * v[0] + v[1] * v[1]) + (v[2] * v[2] + v[3] * v[3]);
            u32x2 w; w.x = pk2(v[0], v[1]); w.y = pk2(v[2], v[3]); xb2[lane + 64 * j] = w; }
#pragma unroll
        for (int o = 1; o < 64; o <<= 1) s += __shfl_xor(s, o);
        if (lane == 0) ss[r] = ss_fix(s); }
}
constexpr int CV_EARLY = 16 * 112 + 16 * 32 + 16 * 32 + 8 * 32 + 8 * 32, CV_MID = CV_EARLY + 16 * 32 + 16 * 128, CV_ALL = CV_MID + 64 * 32;
__global__ void __launch_bounds__(512, 2) mega_fwd(Params p) {
    extern __shared__ __attribute__((aligned(16))) unsigned char lds_raw[];
    LAS unsigned char* lds = (LAS unsigned char*)lds_raw;
    cg::grid_group grid = cg::this_grid();
    const int G = gridDim.x, bx = blockIdx.x;
    if (threadIdx.x < 16) ((LAS unsigned*)(lds + L_BARST))[threadIdx.x] = 0u;
    __syncthreads();
    const XcdBarrier xbar = xcd_barrier_post((unsigned*)(p.ws + WS_CTL + CTL_BAR), (volatile LAS unsigned*)(lds + L_BARST));
#define GSYNC() xcd_barrier(xbar)
    unsigned char* ws = p.ws;
    ssq_t* SS = (ssq_t*)(ws + WS_CTL);
    bf16_t* AB = (bf16_t*)(ws + WS_AB); bf16_t* PJ = (bf16_t*)(ws + WS_P); bf16_t* MX = PJ + C_CA;
    float* BG = (float*)(ws + WS_BG);
    unsigned char* W = ws + WS_W;

    { const int tid_ = otid(), lane = tid_ & 63, gw = bx * 8 + __builtin_amdgcn_readfirstlane(tid_ >> 6), ngw = G * 8;
    for (int r = gw; r < T; r += ngw) { const float* xr = (r < TP) ? p.in[0] + (size_t)r * D : p.in[1] + (size_t)(r - TP) * D; float s = 0.f;
#pragma unroll
        for (int j = 0; j < 4; ++j) { const f32x4 v = *((const f32x4*)xr + lane + 64 * j); s += (v[0] * v[0] + v[1] * v[1]) + (v[2] * v[2] + v[3] * v[3]);
            u32x2 w; w.x = pk2(v[0], v[1]); w.y = pk2(v[2], v[3]); *((u32x2*)(AB + (size_t)r * D) + lane + 64 * j) = w; }
#pragma unroll
        for (int o = 1; o < 64; o <<= 1) s += __shfl_xor(s, o);
        if (lane == 0) SS[r] = ss_fix(s); } }

#pragma unroll 1
    for (int l = 0; l < 2; ++l) {
        ssq_t* ss1 = SS + (size_t)(2 * l) * T; ssq_t* ss2 = SS + (size_t)(2 * l + 1) * T; ssq_t* ss3 = SS + (size_t)(2 * l + 2) * T;
        if (l == 1 && G == 256) convert_weights(p, l, lds, CV_MID, CV_ALL, false, bx * 8, G * 8);
        else convert_weights(p, l, lds, 0, CV_ALL, true, bx * 8, G * 8);
        if (l == 0) grid.sync(); else GSYNC();
        {
            pg8::Gemm g{AB, (const bf16_t*)(W + W_IN), T, 3840, D, D, D}; pg8::StaticOrder S; S.init(T, 3840, G, bx);
            EpiB<0> E{PJ, LDP, ss1, BG, nullptr, 0};
            pg8::gemm_phase<EpiB<0>, true>(lds, g, S, E);
        }
        GSYNC();
        {
            unsigned char* items0 = ws + WS_PRE;
            unsigned char* items1 = (unsigned char*)p.out;
#pragma unroll 1
            for (int pass = 0; pass < 2; ++pass) {
                if ((pass == 0) == ((bx & 1) != 0)) mixer_a_phase(p, l);
                else for (int it = bx; it < 512; it += G) chunk_item(p, l, false, it >> 6, it & 63, items0 + (size_t)it * ITEM_BYTES, lds);
            }
            GSYNC();
            if (bx < 8) scan_chain(p, l, false, bx, 0, 64, items0 + (size_t)bx * 64 * ITEM_BYTES, true, false, lds, false);
            else {
                for (int c = bx - 8; c < 128; c += G - 8) {
                    chunk_item(p, l, true, c, 0, items0 + (size_t)(512 + c) * ITEM_BYTES, lds);
                    __threadfence(); __syncthreads();
                    scan_chain(p, l, true, c, 0, 1, items0 + (size_t)(512 + c) * ITEM_BYTES, true, true, lds, false);
                }
                if (G == 256) {
                    if (bx >= 136) { for (int k = 0; k < 3; ++k) { const int it = (bx - 136) + 120 * k; chunk_item(p, l, false, it >> 6, 64 + (it & 63), items1 + (size_t)it * ITEM_BYTES, lds); } }
                    else { { const int it = 360 + (bx - 8); chunk_item(p, l, false, it >> 6, 64 + (it & 63), items1 + (size_t)it * ITEM_BYTES, lds); }
                        if (bx - 8 < 24) { const int it = 488 + (bx - 8); chunk_item(p, l, false, it >> 6, 64 + (it & 63), items1 + (size_t)it * ITEM_BYTES, lds); } }
                } else { for (int it = bx - 8; it < 512; it += G - 8) chunk_item(p, l, false, it >> 6, 64 + (it & 63), items1 + (size_t)it * ITEM_BYTES, lds); }
                if (G == 256) { const int b2 = bx - 8;
                    if (b2 >= 24 && b2 < 128) { pg8::ListOrder S{1, b2 - 24, 0, T / 256, D / 256};
                        pg8::Gemm g{AB, (const bf16_t*)(W + W_IN) + (size_t)R_GA * D, T, D, D, D, D}; EpiB<2> E{MX, LDP, ss1, nullptr, nullptr, 0}; pg8::gemm_phase<EpiB<2>, true, pg8::ListOrder>(lds, g, S, E); }
                } else { pg8::StaticOrder S; S.init(T, D, G - 8, bx - 8);
                    pg8::Gemm g{AB, (const bf16_t*)(W + W_IN) + (size_t)R_GA * D, T, D, D, D, D}; EpiB<2> E{MX, LDP, ss1, nullptr, nullptr, 0}; pg8::gemm_phase<EpiB<2>, true>(lds, g, S, E); }
            }
            GSYNC();
            if (bx < 8) scan_chain(p, l, false, bx, 64, 64, items1 + (size_t)bx * 64 * ITEM_BYTES, false, true, lds, false);
            else if (G == 256) {
                const int b2 = bx - 8; const int nM = T / 256, nN = D / 256;
                const pg8::Gemm gga{AB, (const bf16_t*)(W + W_IN) + (size_t)R_GA * D, T, D, D, D, D}, gya{PJ + C_BA, (const bf16_t*)(W + W_A), T, D, 512, LDP, 512},
                                ggb{AB, (const bf16_t*)(W + W_IN) + (size_t)R_GB * D, T, D, D, D, D};
                const EpiB<2> Ega{MX, LDP, ss1, nullptr, nullptr, 0}; const EpiB<3> Eya{MX, LDP, nullptr, nullptr, nullptr, 0}; const EpiB<2> Egb{PJ + C_QKV, LDP, ss1, nullptr, nullptr, 0};
                { pg8::ListOrder S{b2 < 160 ? 1 : 0, 104 + b2, 0, nM, nN}; pg8::gemm_phase<EpiB<2>, true, pg8::ListOrder>(lds, gga, S, Ega); }
                { pg8::ListOrder S{1, 0, 0, nM, nN}; if (b2 < 160) { S.u0 = 104 + b2; if (b2 < 16) { S.n = 2; S.u1 = 88 + b2; } } else S.u0 = b2 - 160;
                  pg8::gemm_phase<EpiB<3>, true, pg8::ListOrder>(lds, gya, S, Eya); }
                { pg8::ListOrder S{0, 0, 0, nM, nN}; if (b2 >= 160) { S.n = 2; S.u0 = 2 * (b2 - 160); S.u1 = S.u0 + 1; } else if (b2 >= 16 && b2 < 104) { S.n = 1; S.u0 = 176 + (b2 - 16); }
                  pg8::gemm_phase<EpiB<2>, true, pg8::ListOrder>(lds, ggb, S, Egb); }
                if (b2 >= 104 && b2 < 160) onorm_pass(p, l, lds, 512 + (b2 - 104), 576, 56);
            } else {
                pg8::StaticOrder S; S.init(T, D, G - 8, bx - 8);
                { pg8::Gemm g{PJ + C_BA, (const bf16_t*)(W + W_A), T, D, 512, LDP, 512}; EpiB<3> E{MX, LDP, nullptr, nullptr, nullptr, 0}; pg8::gemm_phase<EpiB<3>, true>(lds, g, S, E); }
                { pg8::Gemm g{AB, (const bf16_t*)(W + W_IN) + (size_t)R_GB * D, T, D, D, D, D}; EpiB<2> E{PJ + C_QKV, LDP, ss1, nullptr, nullptr, 0}; pg8::gemm_phase<EpiB<2>, true>(lds, g, S, E); }
            }
            GSYNC();
        }
        if (G == 256) {
            if (bx >= 8) onorm_pass(p, l, lds, bx - 8, 512, 248);
            else { pg8::UnitOrder S{1, TP / 256 + (bx >> 2), bx & 3};
                pg8::Gemm g{PJ + C_Z, (const bf16_t*)(W + W_B), T, D, 512, LDP, 512}; EpiB<4> E{MX, LDP, nullptr, nullptr, PJ + C_QKV, LDP}; pg8::gemm_phase<EpiB<4>, true, pg8::UnitOrder>(lds, g, S, E); }
        } else onorm_pass(p, l, lds, bx, 576, G);
        GSYNC();
        {
            const int Myb = (G == 256) ? TP : T;
            pg8::StaticOrder S; S.init(Myb, D, G, bx);
            { pg8::Gemm g{PJ + C_Z, (const bf16_t*)(W + W_B), Myb, D, 512, LDP, 512}; EpiB<4> E{MX, LDP, nullptr, nullptr, PJ + C_QKV, LDP}; pg8::gemm_phase<EpiB<4>, true>(lds, g, S, E); }
        }
        GSYNC();
        if (G == 256) {
            unsigned* flag = (unsigned*)(ws + WS_CTL + 900 * 1024) + 64 * l;
            const pg8::Gemm g3{MX, (const bf16_t*)(W + W_O), T, D, D, LDP, D}; const EpiRes E3{AB, ss2};
            if (bx < 8) {
                pg8::UnitOrder Su{1, TP / 256 + (bx >> 2), bx & 3};
                pg8::gemm_phase<EpiRes, true, pg8::UnitOrder>(lds, g3, Su, E3);
                __syncthreads();
                if (threadIdx.x == 0) { __builtin_amdgcn_fence(__ATOMIC_RELEASE, "agent"); asm volatile("s_waitcnt vmcnt(0)" ::: "memory");
                    __hip_atomic_fetch_add(flag, 1u, __ATOMIC_RELAXED, __HIP_MEMORY_SCOPE_AGENT); }
            }
            { pg8::StaticOrder S; S.init(TP, D, G, bx); pg8::gemm_phase<EpiRes, true>(lds, g3, S, E3); }
            if (bx >= 8 && bx < 40) {
                if (threadIdx.x == 0) { unsigned sp = 0;
                    while (__hip_atomic_load(flag, __ATOMIC_RELAXED, __HIP_MEMORY_SCOPE_AGENT) < 8u) { if (++sp > (1u << 22)) break; }
                    __builtin_amdgcn_fence(__ATOMIC_ACQUIRE, "agent"); asm volatile("s_waitcnt vmcnt(0)" ::: "memory"); }
                __syncthreads();
                pg8::UnitOrder Su{1, TP / 256 + ((bx - 8) >> 4), (bx - 8) & 15};
                pg8::Gemm g4{AB, (const bf16_t*)(W + W_UP), T, FF, D, D, D}; EpiB<1> E4{PJ, FF, ss2, nullptr, nullptr, 0};
                pg8::gemm_phase<EpiB<1>, true, pg8::UnitOrder>(lds, g4, Su, E4);
            }
            if (l == 0 && bx >= 40) convert_weights(p, 1, lds, 0, CV_EARLY, true, (bx - 40) * 8, (G - 40) * 8);
            GSYNC();
            {
                pg8::Gemm g{AB, (const bf16_t*)(W + W_UP), TP, FF, D, D, D}; pg8::StaticOrder S; S.init(TP, FF, G, bx);
                EpiB<1> E{PJ, FF, ss2, nullptr, nullptr, 0};
                pg8::gemm_phase<EpiB<1>, true>(lds, g, S, E);
            }
            GSYNC();
        } else {
        {
            pg8::Gemm g{MX, (const bf16_t*)(W + W_O), T, D, D, LDP, D}; pg8::StaticOrder S; S.init(T, D, G, bx);
            EpiRes E{AB, ss2};
            pg8::gemm_phase<EpiRes, true>(lds, g, S, E);
        }
        GSYNC();
        {
            pg8::Gemm g{AB, (const bf16_t*)(W + W_UP), T, FF, D, D, D}; pg8::StaticOrder S; S.init(T, FF, G, bx);
            EpiB<1> E{PJ, FF, ss2, nullptr, nullptr, 0};
            pg8::gemm_phase<EpiB<1>, true>(lds, g, S, E);
        }
        GSYNC();
        }
        {
            pg8::Gemm g{PJ, (const bf16_t*)(W + W_DN), TP, D, FF, FF, FF}; pg8::StaticOrder S; S.init(TP, D, G, bx);
            EpiRes E{AB, ss3};
            pg8::gemm_phase<EpiRes, true>(lds, g, S, E);
            pg8::Gemm g2{PJ, (const bf16_t*)(W + W_DN), T, D, 512, FF, FF}; pg8::SplitOrder S2{G, bx, TP / 256, 8, 64};
            EpiPart E2{(float*)(ws + WS_PART)};
            pg8::gemm_phase<EpiPart, true, pg8::SplitOrder>(lds, g2, S2, E2);
            if (l == 0 && G == 256 && bx >= 64) convert_weights(p, 1, lds, CV_EARLY, CV_MID, false, (bx - 64) * 8, (G - 64) * 8);
        }
        GSYNC();
        if (l == 0) sample_fix(p, ss3);
    }
    { const ssq_t* ssf = SS + (size_t)4 * T; const float* fg = p.in[18]; const int tid_ = otid(), lane = tid_ & 63, gw = bx * 8 + __builtin_amdgcn_readfirstlane(tid_ >> 6), ngw = G * 8;
      const float* part = (const float*)(ws + WS_PART);
      for (int r = gw; r < T; r += ngw) { f32x4* xr = (f32x4*)(p.out + (size_t)r * D); const u32x2* xb2 = (const u32x2*)(AB + (size_t)r * D);
          if (r < TP) { const float rs = rstd_of(ssf, r);
#pragma unroll
              for (int j = 0; j < 4; ++j) { const u32x2 w = xb2[lane + 64 * j]; const f32x4 gq = *((const f32x4*)fg + lane + 64 * j);
                  const f32x4 v = {bflo(w.x), bfhi(w.x), bflo(w.y), bfhi(w.y)}; xr[lane + 64 * j] = v * rs * gq; } }
          else { const int rr = r - TP; u32x2 wq[4]; float sq = 0.f;
#pragma unroll
              for (int j = 0; j < 4; ++j) { const u32x2 w0 = xb2[lane + 64 * j]; f32x4 v = {bflo(w0.x), bfhi(w0.x), bflo(w0.y), bfhi(w0.y)};
#pragma unroll
                  for (int k = 0; k < 8; ++k) v += *((const f32x4*)(part + ((size_t)k * TS + rr) * D) + lane + 64 * j);
                  sq += (v[0] * v[0] + v[1] * v[1]) + (v[2] * v[2] + v[3] * v[3]); wq[j].x = pk2(v[0], v[1]); wq[j].y = pk2(v[2], v[3]); }
#pragma unroll
              for (int o = 1; o < 64; o <<= 1) sq += __shfl_xor(sq, o);
              const float rs = rsqrtf((float)ss_fix(sq) * (1.0f / (1024.0f * 16777216.0f)) + EPS);
#pragma unroll
              for (int j = 0; j < 4; ++j) { const f32x4 gq = *((const f32x4*)fg + lane + 64 * j);
                  const f32x4 v = {bflo(wq[j].x), bfhi(wq[j].x), bflo(wq[j].y), bfhi(wq[j].y)}; xr[lane + 64 * j] = v * rs * gq; } } } }
}

extern "C" void kernel_launch(void* const* d_in, const int* in_sizes, int n_in, void* d_out, int out_size, void* d_ws, size_t ws_size, hipStream_t stream) {
    static int grid = 0;
    if (grid == 0) {
        int dev = 0, cus = 0, per_cu = 0;
        hipGetDevice(&dev); hipDeviceGetAttribute(&cus, hipDeviceAttributeMultiprocessorCount, dev);
        hipFuncSetAttribute((const void*)mega_fwd, hipFuncAttributeMaxDynamicSharedMemorySize, LDS_BYTES);
        hipOccupancyMaxActiveBlocksPerMultiprocessor(&per_cu, (const void*)mega_fwd, 512, LDS_BYTES);
        (void)hipGetLastError();
        if (per_cu < 1) per_cu = 1;
        grid = cus;
        if (grid <= 0) grid = 256;
    }
    hipMemsetAsync((char*)d_ws + WS_CTL, 0, CTL_BYTES, stream);
    Params p{};
    for (int i = 0; i < 19; ++i) p.in[i] = (const float*)d_in[i];
    p.out = (float*)d_out; p.ws = (unsigned char*)d_ws;
    void* args[] = {&p};
    hipError_t e = hipLaunchCooperativeKernel((const void*)mega_fwd, dim3(grid), dim3(512), args, LDS_BYTES, stream);
    if (e != hipSuccess) fprintf(stderr, "cooperative launch failed: %s (grid %d)\n", hipGetErrorString(e), grid);
}
```

```cpp
#include <hip/hip_runtime.h>
#include <hip/hip_cooperative_groups.h>
#include <cstdint>
#include <cstdio>
namespace cg = cooperative_groups;

#define LAS __attribute__((address_space(3)))
typedef unsigned short bf16_t;
typedef short bf16x8 __attribute__((ext_vector_type(8)));
typedef float f32x4 __attribute__((ext_vector_type(4)));
typedef float f32x16 __attribute__((ext_vector_type(16)));
typedef unsigned u32x4 __attribute__((ext_vector_type(4)));
typedef unsigned u32x2 __attribute__((ext_vector_type(2)));
#define DI __device__ __forceinline__

constexpr int TP = 16384, TS = 512, T = TP + TS, D = 1024, FF = 4096, SEQ = 8192, DSEQ = 16, DB = 32;
constexpr int LDP = 3584;
constexpr int C_BA = 0, C_CA = 512, C_XA = 1024, C_QKV = 1536, C_Z = 3072;
constexpr int NW1 = 5888;
constexpr int R_GA = 3840, R_GB = 4864;
constexpr int INW = 5640;
constexpr float EPS = 1e-6f;
constexpr size_t O_PA = (size_t)T * D, O_PQ = O_PA + 4096, O_PS = O_PQ + 18432, O_SA = O_PS + 262144, O_SQ = O_SA + 65536, O_SS = O_SQ + 294912;
constexpr size_t MiB = 1u << 20;
constexpr size_t WS_CTL = 0, CTL_BYTES = 1 * MiB;
constexpr size_t WS_W = 1 * MiB;
constexpr size_t W_IN = 0, W_A = (size_t)NW1 * D * 2, W_B = W_A + 1024 * 512 * 2, W_O = W_B + 1024 * 512 * 2, W_UP = W_O + 1024 * 1024 * 2, W_DN = W_UP + (size_t)FF * D * 2;
constexpr size_t WS_AB = 33 * MiB;
constexpr size_t WS_P = 66 * MiB;
constexpr size_t WS_PRE = 182 * MiB;
constexpr size_t WS_BG = 230 * MiB;
constexpr size_t WS_SB = 231 * MiB;
constexpr size_t WS_PART = 232 * MiB;
constexpr size_t OUT_OT = 40 * MiB;
constexpr int ITEM_BYTES = 74240, IT_WK = 0, IT_QG = 16384, IT_KT = 32768, IT_PP = 49152, IT_WV = 57344, IT_GL = 73728;
constexpr int LDS_BYTES = 159744 + 64, L_BARST = 159744;
constexpr size_t CTL_BAR = 768 * 1024;

typedef __bf16 bf16x2_t __attribute__((ext_vector_type(2)));
typedef float f32x2 __attribute__((ext_vector_type(2)));
DI unsigned pk2(float lo, float hi) { const f32x2 v = {lo, hi}; const bf16x2_t r = __builtin_convertvector(v, bf16x2_t); return __builtin_bit_cast(unsigned, r); }
DI unsigned f2bf(float f) { return pk2(f, 0.f) & 0xffffu; }
DI float bf2f(unsigned short b) { return __builtin_bit_cast(float, (unsigned)b << 16); }
DI float bflo(unsigned u) { return __builtin_bit_cast(float, u << 16); }
DI float bfhi(unsigned u) { return __builtin_bit_cast(float, u & 0xffff0000u); }
DI float sigm(float x) { return __builtin_amdgcn_rcpf(1.0f + __expf(-x)); }
DI int otid() { int t = threadIdx.x; asm volatile("" : "+v"(t)); return t; }
DI void lds_barrier() { asm volatile("s_waitcnt lgkmcnt(0)" ::: "memory"); __builtin_amdgcn_s_barrier(); asm volatile("" ::: "memory"); }
DI int perm16(int x) { return (x & ~15) | (((x >> 2) & 1) << 3) | (((x >> 3) & 1) << 2) | (x & 3); }

namespace pg8 {
constexpr int BM = 256, BK = 64, HALF = 128, HTB = HALF * BK * 2, STAGE_BYTES = 8 * HTB, NXCD = 8, WGM = 8;
__host__ __device__ __forceinline__ int lds_byte(int r, int c) { const int st = (r >> 4) * 2 + (c >> 5), rr = r & 15, cc = c & 31, ob = rr * 64 + cc * 2; return st * 1024 + (ob ^ (((ob >> 9) & 1) << 5)); }
__host__ __device__ __forceinline__ void stage_rc(int b, int& R, int& C) { const int st = b / 1024, sb = b % 1024, swz = sb ^ (((sb >> 9) & 1) << 5); R = (st >> 1) * 16 + swz / 64; C = (st & 1) * 32 + (swz % 64) / 2; }
__host__ __device__ __forceinline__ int perm32(int rho) { const int n = rho >> 4, i = rho & 15; return 8 * (i >> 2) + 4 * n + (i & 3); }
struct Unit { int pm, pn, ks; };
struct Gemm { const bf16_t* A; const bf16_t* Bt; int M, N, K, lda, ldb; };
struct StaticOrder {
    int nM, nN, nwg, G, c;
    __device__ void init(int M, int N, int G_, int c_) { nM = M / BM; nN = N / BM; nwg = nM * nN; G = G_; c = c_; }
    __device__ bool next(int i, Unit& u) const {
        const long L = (long)i * G + c; if (L >= nwg) return false;
        int wgid = (int)L; { const int q = nwg / NXCD, r = nwg % NXCD, xcd = wgid % NXCD, off = wgid / NXCD; wgid = (xcd < r ? xcd * (q + 1) : r * (q + 1) + (xcd - r) * q) + off; }
        const int nig = WGM * nN, gid = wgid / nig, fm = gid * WGM, gsz = (nM - fm) < WGM ? (nM - fm) : WGM;
        u.pm = fm + ((wgid % nig) % gsz); u.pn = (wgid % nig) / gsz; u.ks = 0; return true;
    }
};

struct ListOrder {
    int n, u0, u1, nM, nN;
    __device__ bool next(int i, Unit& u) const {
        if (i >= n) return false;
        int wgid = i == 0 ? u0 : u1; const int nwg = nM * nN;
        { const int q = nwg / NXCD, r = nwg % NXCD, xcd = wgid % NXCD, off = wgid / NXCD; wgid = (xcd < r ? xcd * (q + 1) : r * (q + 1) + (xcd - r) * q) + off; }
        const int nig = WGM * nN, gid = wgid / nig, fm = gid * WGM, gsz = (nM - fm) < WGM ? (nM - fm) : WGM;
        u.pm = fm + ((wgid % nig) % gsz); u.pn = (wgid % nig) / gsz; u.ks = 0; return true;
    }
};
struct UnitOrder { int n, pm, pn; __device__ bool next(int i, Unit& u) const { if (i >= n) return false; u.pm = pm; u.pn = pn; u.ks = 0; return true; } };
struct SplitOrder {
    int G, c, pm0, ns, n;
    __device__ bool next(int i, Unit& u) const { const int L = i * G + c; if (L >= n) return false; u.ks = L % ns; u.pn = (L / ns) & 3; u.pm = pm0 + L / (4 * ns); return true; }
};
template <class Epi, bool ALIGN_EPI, class Sched = StaticOrder>
__device__ __forceinline__ void gemm_phase(LAS unsigned char* lds, const Gemm g, const Sched& S, const Epi& E) {
    const int tid = otid(), wid = __builtin_amdgcn_readfirstlane(tid >> 6), lane = tid & 63, wr = wid >> 2, wc = wid & 3, fr = lane & 15, fq = lane >> 4;
    const int K = g.K, nt = K / BK;
    unsigned voffA[2], voffB[2];
#pragma unroll
    for (int i = 0; i < 2; ++i) { int R, C; stage_rc(tid * 16 + i * 8192, R, C); const int Rb = Epi::PERM ? ((R & ~31) + perm32(R & 31)) : R;
        voffA[i] = (unsigned)(R * g.lda + C) * 2u; voffB[i] = (unsigned)(Rb * g.ldb + C) * 2u; }
    const size_t kstep = (size_t)(BK * 2);
    const size_t hstepA = (size_t)HALF * g.lda * 2, hstepB = (size_t)HALF * g.ldb * 2;
    const size_t tstepA = 2 * hstepA, tstepB = 2 * hstepB;
    const unsigned ldsw = (unsigned)wid * 1024u;
    const int aoff = lds_byte(wr * 64 + fr, fq * 8), boff = lds_byte(wc * 32 + fr, fq * 8);
#define PG8_SA(b, h) (((b) * 2 + (h)) * HTB)
#define PG8_SB(b, h) ((4 + (b) * 2 + (h)) * HTB)
#define PG8_STAGE(bufoff, gbase, voff) do { _Pragma("unroll") for (int _i = 0; _i < 2; ++_i) \
        __builtin_amdgcn_global_load_lds((const unsigned*)((const char*)(gbase) + (voff)[_i]), (LAS unsigned*)(lds + (bufoff) + ldsw + _i * 8192), 16, 0, 0); } while (0)
#define PG8_LDA(dst, b, h) do { _Pragma("unroll") for (int m = 0; m < 4; ++m) _Pragma("unroll") for (int k = 0; k < 2; ++k) dst[m][k] = *(const LAS bf16x8*)(lds + PG8_SA(b, h) + aoff + m * 2048 + k * 1024); } while (0)
#define PG8_LDB(dst, b, h) do { _Pragma("unroll") for (int n = 0; n < 2; ++n) _Pragma("unroll") for (int k = 0; k < 2; ++k) dst[n][k] = *(const LAS bf16x8*)(lds + PG8_SB(b, h) + boff + n * 2048 + k * 1024); } while (0)
#define PG8_MMA(ai, bj, At, Bt) do { __builtin_amdgcn_s_setprio(1); _Pragma("unroll") for (int m = 0; m < 4; ++m) _Pragma("unroll") for (int n = 0; n < 2; ++n) _Pragma("unroll") for (int k = 0; k < 2; ++k) \
        acc[ai][bj][m][n] = __builtin_amdgcn_mfma_f32_16x16x32_bf16(Bt[n][k], At[m][k], acc[ai][bj][m][n], 0, 0, 0); __builtin_amdgcn_s_setprio(0); } while (0)
#define PG8_WAIT_V(n) asm volatile("s_waitcnt vmcnt(" #n ")" ::: "memory")
#define PG8_WAIT_L(n) asm volatile("s_waitcnt lgkmcnt(" #n ")" ::: "memory")
#define PG8_BAR __builtin_amdgcn_s_barrier()
#define PG8_SCHED __builtin_amdgcn_sched_barrier(0)
    Unit cur, nxt; int ui = 0;
    if (!S.next(0, cur)) return;
    f32x4 acc[2][2][4][2];
#pragma unroll
    for (int a = 0; a < 2; ++a)
#pragma unroll
        for (int b = 0; b < 2; ++b)
#pragma unroll
            for (int m = 0; m < 4; ++m)
#pragma unroll
                for (int n = 0; n < 2; ++n) acc[a][b][m][n] = (f32x4){0.f, 0.f, 0.f, 0.f};
    bf16x8 At[4][2], B0[2][2], B1[2][2];
    const size_t ksb = (size_t)K * 2;
    const char* cA = (const char*)g.A + (size_t)cur.pm * tstepA + cur.ks * ksb; const char* cB = (const char*)g.Bt + (size_t)cur.pn * tstepB + cur.ks * ksb;
    PG8_STAGE(PG8_SB(0, 0), cB, voffB); PG8_STAGE(PG8_SB(0, 1), cB + hstepB, voffB); PG8_STAGE(PG8_SA(0, 0), cA, voffA); PG8_STAGE(PG8_SA(0, 1), cA + hstepA, voffA);
    if (wr == 1) PG8_BAR;
    PG8_WAIT_V(2); PG8_BAR;
    PG8_STAGE(PG8_SB(1, 0), cB + kstep, voffB); PG8_STAGE(PG8_SA(1, 0), cA + kstep, voffA); PG8_STAGE(PG8_SB(1, 1), cB + hstepB + kstep, voffB);
    PG8_WAIT_V(6); PG8_BAR;
    for (;;) {
        const bool has_next = S.next(ui + 1, nxt);
        const char* nA = has_next ? (const char*)g.A + (size_t)nxt.pm * tstepA + nxt.ks * ksb : cA; const char* nB = has_next ? (const char*)g.Bt + (size_t)nxt.pn * tstepB + nxt.ks * ksb : cB;
        for (int t = 0; t < nt; t += 2) {
            const bool last = (t == nt - 2);
            const char* a1 = cA + (size_t)(t + 1) * kstep;
            const char* a2 = last ? nA : cA + (size_t)(t + 2) * kstep; const char* b2 = last ? nB : cB + (size_t)(t + 2) * kstep;
            const char* a3 = a2 + kstep; const char* b3 = b2 + kstep;
            const bool dead = last && !has_next;
            unsigned vA2[2], vB2[2];
            vA2[0] = dead ? 0u : voffA[0]; vA2[1] = dead ? 0u : voffA[1]; vB2[0] = dead ? 0u : voffB[0]; vB2[1] = dead ? 0u : voffB[1];
            PG8_LDB(B0, 0, 0); PG8_LDB(B1, 0, 1); PG8_SCHED; PG8_LDA(At, 0, 0); PG8_STAGE(PG8_SA(1, 1), a1 + hstepA, voffA);
            PG8_WAIT_V(8); PG8_WAIT_L(0); PG8_BAR; PG8_MMA(0, 0, At, B0); PG8_MMA(0, 1, At, B1); PG8_BAR; PG8_SCHED;
            PG8_LDA(At, 0, 1); PG8_STAGE(PG8_SB(0, 0), b2, vB2); PG8_STAGE(PG8_SB(0, 1), dead ? b2 : b2 + hstepB, vB2); PG8_STAGE(PG8_SA(0, 0), a2, vA2);
            PG8_WAIT_V(8); PG8_WAIT_L(0); PG8_BAR; PG8_MMA(1, 0, At, B0); PG8_MMA(1, 1, At, B1); PG8_BAR; PG8_SCHED;
            PG8_LDB(B0, 1, 0); PG8_LDB(B1, 1, 1); PG8_SCHED; PG8_LDA(At, 1, 0); PG8_STAGE(PG8_SA(0, 1), dead ? a2 : a2 + hstepA, vA2);
            PG8_WAIT_V(8); PG8_WAIT_L(0); PG8_BAR; PG8_MMA(0, 0, At, B0); PG8_MMA(0, 1, At, B1); PG8_BAR; PG8_SCHED;
            PG8_LDA(At, 1, 1); PG8_STAGE(PG8_SB(1, 0), dead ? b2 : b3, vB2); PG8_STAGE(PG8_SB(1, 1), dead ? b2 : b3 + hstepB, vB2); PG8_STAGE(PG8_SA(1, 0), dead ? a2 : a3, vA2);
            PG8_WAIT_V(8); PG8_WAIT_L(0); PG8_BAR; PG8_MMA(1, 0, At, B0); PG8_MMA(1, 1, At, B1); PG8_BAR; PG8_SCHED;
        }
        if constexpr (ALIGN_EPI) { if (wr == 0) PG8_BAR; }
        E(acc, cur, wr, wc, fr, fq);
        if (!has_next) break;
#pragma unroll
        for (int a = 0; a < 2; ++a)
#pragma unroll
            for (int b = 0; b < 2; ++b)
#pragma unroll
                for (int m = 0; m < 4; ++m)
#pragma unroll
                    for (int n = 0; n < 2; ++n) acc[a][b][m][n] = (f32x4){0.f, 0.f, 0.f, 0.f};
        cur = nxt; cA = nA; cB = nB; ++ui;
        if constexpr (ALIGN_EPI) { if (wr == 1) PG8_BAR; }
    }
    PG8_WAIT_V(0);
    if constexpr (!ALIGN_EPI) { if (wr == 0) PG8_BAR; }
    PG8_BAR;
#undef PG8_SA
#undef PG8_SB
#undef PG8_STAGE
#undef PG8_LDA
#undef PG8_LDB
#undef PG8_MMA
#undef PG8_WAIT_V
#undef PG8_WAIT_L
#undef PG8_BAR
#undef PG8_SCHED
}
}

typedef f32x4 Acc[2][2][4][2];
typedef unsigned long long ssq_t;
DI ssq_t ss_fix(float s) { return (ssq_t)(s * 16777216.0f); }
DI float rstd_of(const ssq_t* ss, int r) { return rsqrtf((float)ss[r] * (1.0f / (1024.0f * 16777216.0f)) + EPS); }

template <int MODE> struct EpiB {
    static constexpr bool PERM = true;
    bf16_t* O; int ldc; const ssq_t* ss; float* bg; const bf16_t* aux; int ldaux;
    DI void operator()(const Acc& acc, const pg8::Unit& u, int wr, int wc, int fr, int fq) const {
        const int row0 = u.pm * 256 + wr * 64 + fr, col0 = u.pn * 256 + wc * 32 + 8 * fq;
        if (MODE == 0 && u.pn == 14) {
            if (wc == 0 && fq == 0) {
#pragma unroll
                for (int ai = 0; ai < 2; ++ai)
#pragma unroll
                    for (int m = 0; m < 4; ++m) { const int r = row0 + ai * 128 + m * 16; const float rs = rstd_of(ss, r);
                        *(f32x4*)(bg + (size_t)r * 8) = acc[ai][0][m][0] * rs; *(f32x4*)(bg + (size_t)r * 8 + 4) = acc[ai][0][m][1] * rs; }
            }
            return;
        }
        float rsv[2][4];
#pragma unroll
        for (int ai = 0; ai < 2; ++ai)
#pragma unroll
            for (int m = 0; m < 4; ++m) rsv[ai][m] = (MODE <= 2) ? rstd_of(ss, row0 + ai * 128 + m * 16) : 1.f;
#pragma unroll
        for (int ai = 0; ai < 2; ++ai)
#pragma unroll
            for (int m = 0; m < 4; ++m) { const int r = row0 + ai * 128 + m * 16; const float rs = rsv[ai][m];
                bf16_t* rowp = O + (size_t)r * ldc + col0;
#pragma unroll
                for (int bj = 0; bj < 2; ++bj) { f32x4 v0 = acc[ai][bj][m][0], v1 = acc[ai][bj][m][1];
                    if (MODE <= 2) { v0 = v0 * rs; v1 = v1 * rs; }
                    if (MODE == 1) {
#pragma unroll
                        for (int e = 0; e < 4; ++e) { float a = fmaxf(v0[e], 0.f), b = fmaxf(v1[e], 0.f); v0[e] = a * a; v1[e] = b * b; } }
                    if (MODE == 2) {
#pragma unroll
                        for (int e = 0; e < 4; ++e) { v0[e] = sigm(v0[e]); v1[e] = sigm(v1[e]); } }
                    if (MODE == 3) { const u32x4 o = *(const u32x4*)(rowp + bj * 128);
                        v0[0] *= bflo(o.x); v0[1] *= bfhi(o.x); v0[2] *= bflo(o.y); v0[3] *= bfhi(o.y); v1[0] *= bflo(o.z); v1[1] *= bfhi(o.z); v1[2] *= bflo(o.w); v1[3] *= bfhi(o.w); }
                    if (MODE == 4) { const u32x4 o = *(const u32x4*)(rowp + bj * 128); const u32x4 s = *(const u32x4*)(aux + (size_t)r * ldaux + col0 + bj * 128);
                        v0[0] = bflo(o.x) + bflo(s.x) * v0[0]; v0[1] = bfhi(o.x) + bfhi(s.x) * v0[1]; v0[2] = bflo(o.y) + bflo(s.y) * v0[2]; v0[3] = bfhi(o.y) + bfhi(s.y) * v0[3];
                        v1[0] = bflo(o.z) + bflo(s.z) * v1[0]; v1[1] = bfhi(o.z) + bfhi(s.z) * v1[1]; v1[2] = bflo(o.w) + bflo(s.w) * v1[2]; v1[3] = bfhi(o.w) + bfhi(s.w) * v1[3]; }
                    u32x4 w; w.x = pk2(v0[0], v0[1]); w.y = pk2(v0[2], v0[3]); w.z = pk2(v1[0], v1[1]); w.w = pk2(v1[2], v1[3]);
                    *(u32x4*)(rowp + bj * 128) = w; } }
    }
};
struct EpiRes {
    static constexpr bool PERM = true;
    bf16_t* xb; ssq_t* ssn;
    DI void operator()(const Acc& acc, const pg8::Unit& u, int wr, int wc, int fr, int fq) const {
        const int row0 = u.pm * 256 + wr * 64 + fr, col0 = u.pn * 256 + wc * 32 + 8 * fq;
#pragma unroll
        for (int ai = 0; ai < 2; ++ai)
#pragma unroll
            for (int m = 0; m < 4; ++m) { const int r = row0 + ai * 128 + m * 16; float s = 0.f; bf16_t* rowp = xb + (size_t)r * D + col0;
#pragma unroll
                for (int bj = 0; bj < 2; ++bj) { const u32x4 o = *(const u32x4*)(rowp + bj * 128); f32x4 v0 = acc[ai][bj][m][0], v1 = acc[ai][bj][m][1];
                    v0[0] += bflo(o.x); v0[1] += bfhi(o.x); v0[2] += bflo(o.y); v0[3] += bfhi(o.y); v1[0] += bflo(o.z); v1[1] += bfhi(o.z); v1[2] += bflo(o.w); v1[3] += bfhi(o.w);
                    s += (v0[0] * v0[0] + v0[1] * v0[1]) + (v0[2] * v0[2] + v0[3] * v0[3]) + (v1[0] * v1[0] + v1[1] * v1[1]) + (v1[2] * v1[2] + v1[3] * v1[3]);
                    u32x4 w; w.x = pk2(v0[0], v0[1]); w.y = pk2(v0[2], v0[3]); w.z = pk2(v1[0], v1[1]); w.w = pk2(v1[2], v1[3]);
                    *(u32x4*)(rowp + bj * 128) = w; }
                s += __shfl_xor(s, 16); s += __shfl_xor(s, 32);
                if (fq == 0) __hip_atomic_fetch_add(ssn + r, ss_fix(s), __ATOMIC_RELAXED, __HIP_MEMORY_SCOPE_AGENT); }
    }
};
struct EpiPart {
    static constexpr bool PERM = false;
    float* part;
    DI void operator()(const Acc& acc, const pg8::Unit& u, int wr, int wc, int fr, int fq) const {
        const int row0 = u.pm * 256 + wr * 64 + fr - TP, col0 = u.pn * 256 + wc * 32 + 4 * fq; float* pp = part + (size_t)u.ks * TS * D;
#pragma unroll
        for (int ai = 0; ai < 2; ++ai)
#pragma unroll
            for (int m = 0; m < 4; ++m) { const int r = row0 + ai * 128 + m * 16;
#pragma unroll
                for (int bj = 0; bj < 2; ++bj)
#pragma unroll
                    for (int n = 0; n < 2; ++n) *(f32x4*)(pp + (size_t)r * D + col0 + bj * 128 + n * 16) = acc[ai][bj][m][n]; }
    }
};

#define XB_TMO      128
#define XB_XCNT(j)  (256  + 64 * (j))
#define XB_XSUB(j)  (1280 + 64 * (j))
#define XB_XGEN(j)  (2304 + 64 * (j))
#define XB_TOP      3328
#define XB_TOPGEN   3392
#define XB_SPIN_CAP (1u << 20)
DI unsigned xb_ld(unsigned* p)              { return __hip_atomic_load(p, __ATOMIC_RELAXED, __HIP_MEMORY_SCOPE_AGENT); }
DI unsigned xb_add(unsigned* p, unsigned v) { return __hip_atomic_fetch_add(p, v, __ATOMIC_RELAXED, __HIP_MEMORY_SCOPE_AGENT); }
DI unsigned xb_xcc_id() { return (unsigned)__builtin_amdgcn_s_getreg((3 << 11) | 20) & 0xFu; }
#define XB_SPIN(cond, bar) do { unsigned _sp = 0; while (cond) { \
    if ((++_sp & 255u) == 0u) { if (xb_ld(&(bar)[XB_TMO])) break; if (_sp > XB_SPIN_CAP) { atomicAdd(&(bar)[XB_TMO], 1u); break; } } } } while (0)
struct XcdBarrier { unsigned* bar; unsigned x; volatile LAS unsigned* st; };
DI XcdBarrier xcd_barrier_post(unsigned* bar, volatile LAS unsigned* st) {
    XcdBarrier b; b.bar = bar; b.x = xb_xcc_id(); b.st = st;
    if (threadIdx.x == 0) (void)xb_add(&bar[XB_XCNT(b.x)], 1u);
    return b;
}
DI void xcd_barrier_complete(unsigned* bar, unsigned x, unsigned& nloc, unsigned& nx) {
    const unsigned G = gridDim.x * gridDim.y * gridDim.z;
    unsigned sum, cnt, mine, sp = 0u;
    for (;;) {
        sum = 0u; cnt = 0u; mine = 0u;
#pragma unroll
        for (unsigned j = 0; j < 16; ++j) { const unsigned c = xb_ld(&bar[XB_XCNT(j)]); sum += c; cnt += (c > 0u) ? 1u : 0u; mine = (j == x) ? c : mine; }
        if (sum == G) break;
        __builtin_amdgcn_s_sleep(1);
        if ((++sp & 255u) == 0u) { if (xb_ld(&bar[XB_TMO])) break; if (sp > XB_SPIN_CAP) { atomicAdd(&bar[XB_TMO], 1u); break; } }
    }
    nloc = mine > 0u ? mine : 1u; nx = cnt > 0u ? cnt : 1u;
}
DI void xcd_barrier(const XcdBarrier& b) {
    asm volatile("s_waitcnt vmcnt(0)" ::: "memory");
    __syncthreads();
    if (threadIdx.x == 0) {
        unsigned* bar = b.bar;
        __builtin_amdgcn_s_waitcnt(0);
        unsigned nloc = b.st[0], nx = b.st[1];
        if (nloc == 0u) { xcd_barrier_complete(bar, b.x, nloc, nx); b.st[0] = nloc; b.st[1] = nx; }
        const unsigned old = xb_add(&bar[XB_XSUB(b.x)], 1u);
        const unsigned gen = old / nloc;
        if (old + 1u == (gen + 1u) * nloc) {
            __builtin_amdgcn_fence(__ATOMIC_RELEASE, "agent");
            asm volatile("s_waitcnt vmcnt(0)" ::: "memory");
            const unsigned og = xb_add(&bar[XB_TOP], 1u);
            const unsigned tg = og / nx;
            if (og + 1u == (tg + 1u) * nx) xb_add(&bar[XB_TOPGEN], 1u);
            else XB_SPIN(xb_ld(&bar[XB_TOPGEN]) == tg, bar);
            __builtin_amdgcn_fence(__ATOMIC_ACQUIRE, "agent");
            xb_add(&bar[XB_XGEN(b.x)], 1u);
            asm volatile("s_waitcnt vmcnt(0)" ::: "memory");
        } else {
            XB_SPIN(xb_ld(&bar[XB_XGEN(b.x)]) == gen, bar);
            __builtin_amdgcn_fence(__ATOMIC_ACQUIRE, "agent");
            asm volatile("s_waitcnt vmcnt(0)" ::: "memory");
        }
    }
    __syncthreads();
}

struct Params {
    const float* in[19]; float* out; unsigned char* ws;
};

DI void tr_item(const float* src, int ldsrc, int col0, bf16_t* dst, int K, int row0, const float* scale, int ncb, LAS float* scr, int item, int lane) {
    const int kb = item / ncb, nb = item % ncb, k0 = 64 * kb, n0 = 32 * nb;
#pragma unroll
    for (int i = 0; i < 32; ++i) { const int kk = 2 * i + (lane >> 5); float v = src[(size_t)(k0 + kk) * ldsrc + col0 + n0 + (lane & 31)]; if (scale) v *= scale[k0 + kk]; scr[kk * 33 + (lane & 31)] = v; }
    asm volatile("s_waitcnt lgkmcnt(0)" ::: "memory");
    const int c = lane & 7;
#pragma unroll
    for (int j = 0; j < 4; ++j) { const int n = (lane >> 3) + 8 * j; const LAS float* s = scr + (8 * c) * 33 + n;
        u32x4 o; o.x = pk2(s[0 * 33], s[1 * 33]); o.y = pk2(s[2 * 33], s[3 * 33]); o.z = pk2(s[4 * 33], s[5 * 33]); o.w = pk2(s[6 * 33], s[7 * 33]);
        *(u32x4*)(dst + (size_t)(row0 + n0 + n) * K + k0 + 8 * c) = o; }
    asm volatile("s_waitcnt lgkmcnt(0)" ::: "memory");
}
DI void convert_weights(const Params& p, int l, LAS unsigned char* lds, int it0, int it1, bool tail, int gw0, int ngw) {
    const int tid_ = otid(), lane = tid_ & 63, wave = __builtin_amdgcn_readfirstlane(tid_ >> 6), gw = gw0 + wave;
    LAS float* scr = (LAS float*)(lds + wave * 8704);
    unsigned char* W = p.ws + WS_W;
    const float* w_in = p.in[6] + (size_t)l * D * INW; const float* g1 = p.in[5] + l * D; const float* g2 = p.in[15] + l * D;
    constexpr int I0 = 16 * 112, I1 = 16 * 32, I2 = 16 * 32, I3 = 8 * 32, I4 = 8 * 32, I5 = 16 * 32, I6 = 16 * 128, I7 = 64 * 32;
    constexpr int NIT = I0 + I1 + I2 + I3 + I4 + I5 + I6 + I7;
    for (int it = it0 + gw; it < it1; it += ngw) {
        int r = it;
        if (r < I0) { tr_item(w_in, INW, 0, (bf16_t*)(W + W_IN), D, 0, g1, 112, scr, r, lane); continue; } r -= I0;
        if (r < I1) { tr_item(w_in, INW, 3592, (bf16_t*)(W + W_IN), D, R_GA, g1, 32, scr, r, lane); continue; } r -= I1;
        if (r < I2) { tr_item(w_in, INW, 4616, (bf16_t*)(W + W_IN), D, R_GB, g1, 32, scr, r, lane); continue; } r -= I2;
        if (r < I3) { tr_item(p.in[8] + (size_t)l * 512 * D, D, 0, (bf16_t*)(W + W_A), 512, 0, nullptr, 32, scr, r, lane); continue; } r -= I3;
        if (r < I4) { tr_item(p.in[13] + (size_t)l * 512 * D, D, 0, (bf16_t*)(W + W_B), 512, 0, nullptr, 32, scr, r, lane); continue; } r -= I4;
        if (r < I5) { tr_item(p.in[14] + (size_t)l * D * D, D, 0, (bf16_t*)(W + W_O), D, 0, nullptr, 32, scr, r, lane); continue; } r -= I5;
        if (r < I6) { tr_item(p.in[16] + (size_t)l * D * FF, FF, 0, (bf16_t*)(W + W_UP), D, 0, g2, 128, scr, r, lane); continue; } r -= I6;
        tr_item(p.in[17] + (size_t)l * FF * D, D, 0, (bf16_t*)(W + W_DN), FF, 0, nullptr, 32, scr, r, lane);
    }
    bf16_t* wi = (bf16_t*)(W + W_IN);
    if (tail)
    for (int e = gw * 64 + lane; e < 256 * D; e += ngw * 64) { const int n = e >> 10, k = e & 1023; float v = 0.f; if (n < 8) v = w_in[(size_t)k * INW + 3584 + n] * g1[k]; wi[(size_t)(3584 + n) * D + k] = (bf16_t)f2bf(v); }
}

DI void mixer_a_phase(const Params& p, int l) {
    const int gtid = blockIdx.x * 512 + otid(), gthreads = gridDim.x * 512;
    bf16_t* P = (bf16_t*)(p.ws + WS_P);
    const float* cw = p.in[7] + (size_t)l * 3 * 512;
    const float* sca = p.in[2] + (size_t)l * DB * 2 * 512;
    for (int it = gtid; it < T * 64; it += gthreads) {
        const int r = it >> 6, c0 = (it & 63) * 8;
        int t, b; bool smp = r >= TP; if (!smp) { b = r >> 13; t = r & 8191; } else { b = (r - TP) >> 4; t = (r - TP) & 15; }
        float cx[3][8];
#pragma unroll
        for (int j = 0; j < 3; ++j) { const int tt = t - 2 + j;
            if (tt >= 0) { const u32x4 ca = *(const u32x4*)(P + (size_t)(r - 2 + j) * LDP + C_CA + c0); const u32x4 xa = *(const u32x4*)(P + (size_t)(r - 2 + j) * LDP + C_XA + c0);
                cx[j][0] = bflo(ca.x) * bflo(xa.x); cx[j][1] = bfhi(ca.x) * bfhi(xa.x); cx[j][2] = bflo(ca.y) * bflo(xa.y); cx[j][3] = bfhi(ca.y) * bfhi(xa.y);
                cx[j][4] = bflo(ca.z) * bflo(xa.z); cx[j][5] = bfhi(ca.z) * bfhi(xa.z); cx[j][6] = bflo(ca.w) * bflo(xa.w); cx[j][7] = bfhi(ca.w) * bfhi(xa.w); }
            else if (smp) { const float* s = sca + ((size_t)b * 2 + (2 + tt)) * 512 + c0;
#pragma unroll
                for (int e = 0; e < 8; ++e) cx[j][e] = s[e]; }
            else {
#pragma unroll
                for (int e = 0; e < 8; ++e) cx[j][e] = 0.f; } }
        const u32x4 ba = *(const u32x4*)(P + (size_t)r * LDP + C_BA + c0);
        float bv[8] = {bflo(ba.x), bfhi(ba.x), bflo(ba.y), bfhi(ba.y), bflo(ba.z), bfhi(ba.z), bflo(ba.w), bfhi(ba.w)};
        float o[8];
#pragma unroll
        for (int e = 0; e < 8; ++e) { const float u = cx[0][e] * cw[c0 + e] + cx[1][e] * cw[512 + c0 + e] + cx[2][e] * cw[1024 + c0 + e]; o[e] = bv[e] * u; }
        u32x4 w; w.x = pk2(o[0], o[1]); w.y = pk2(o[2], o[3]); w.z = pk2(o[4], o[5]); w.w = pk2(o[6], o[7]);
        *(u32x4*)(P + (size_t)r * LDP + C_BA + c0) = w;
        {
            const u32x4 zq = *(const u32x4*)(P + (size_t)r * LDP + C_Z + c0);
            float zv[8] = {bflo(zq.x), bfhi(zq.x), bflo(zq.y), bfhi(zq.y), bflo(zq.z), bfhi(zq.z), bflo(zq.w), bfhi(zq.w)};
#pragma unroll
            for (int e = 0; e < 8; ++e) zv[e] = zv[e] * sigm(zv[e]);
            u32x4 zw; zw.x = pk2(zv[0], zv[1]); zw.y = pk2(zv[2], zv[3]); zw.z = pk2(zv[4], zv[5]); zw.w = pk2(zv[6], zv[7]);
            *(u32x4*)(P + (size_t)r * LDP + C_Z + c0) = zw; }
        const int L = smp ? DSEQ : SEQ;
        if (t >= L - 2) { float* dst = smp ? p.out + O_SA + (((size_t)l * DB + b) * 2 + (t - (L - 2))) * 512 + c0 : p.out + O_PA + (((size_t)l * 2 + b) * 2 + (t - (L - 2))) * 512 + c0;
#pragma unroll
            for (int e = 0; e < 8; ++e) dst[e] = cx[2][e]; }
    }
    for (int it = gtid; it < (2 + DB) * 3 * 1536; it += gthreads) {
        const int c = it % 1536, j = (it / 1536) % 3, sb = it / (3 * 1536);
        if (sb < 2) { const int r = sb * SEQ + SEQ - 3 + j; p.out[O_PQ + (((size_t)l * 2 + sb) * 3 + j) * 1536 + c] = bf2f(P[(size_t)r * LDP + C_QKV + c]); }
        else { const int b = sb - 2, r = TP + b * DSEQ + DSEQ - 3 + j; p.out[O_SQ + (((size_t)l * DB + b) * 3 + j) * 1536 + c] = bf2f(P[(size_t)r * LDP + C_QKV + c]); }
    }
}

constexpr int L_SCR = 0, L_QB = 33792, L_KB = 51200, L_VB = 68608, L_AM = 86016, L_GC = 103424, L_BE = 103680, L_RN = 103936, L_EG = 104192, L_SOL = 104448;
DI void chunk_item(const Params& p, int l, bool smp, int chain, int n, unsigned char* item, LAS unsigned char* lds) {
    const int tid = otid(), lane = tid & 63, wave = tid >> 6;
    const bf16_t* P = (const bf16_t*)(p.ws + WS_P); const float* BG = (const float*)(p.ws + WS_BG);
    const int h = chain & 3, bb = chain >> 2;
    const int r0 = smp ? TP + bb * DSEQ : bb * SEQ + n * 64;
    const int nvalid = smp ? DSEQ : 64;
    const bool hist_proj = (!smp) && n > 0;
    LAS float* SCR = (LAS float*)(lds + L_SCR); LAS bf16_t* QB = (LAS bf16_t*)(lds + L_QB); LAS bf16_t* KB = (LAS bf16_t*)(lds + L_KB); LAS bf16_t* VB = (LAS bf16_t*)(lds + L_VB);
    LAS float* AM = (LAS float*)(lds + L_AM); LAS float* GC = (LAS float*)(lds + L_GC); LAS float* BE = (LAS float*)(lds + L_BE); LAS float* RN = (LAS float*)(lds + L_RN); LAS float* EG = (LAS float*)(lds + L_EG);
    const int col = tid & 127, rq = tid >> 7;
    const float* cqw = p.in[9] + (size_t)l * 4 * 1536;
    const float* scq = p.in[3] + ((size_t)l * DB + bb) * 3 * 1536;
    if (wave == 0) {
        const int i = lane; const bool valid = i < nvalid;
        float be = 0.f, g = 0.f;
        if (valid) { const float br = BG[(size_t)(r0 + i) * 8 + h], ar = BG[(size_t)(r0 + i) * 8 + 4 + h];
            be = sigm(br); const float xx = ar + p.in[11][l * 4 + h]; const float sp = xx > 20.f ? xx : log1pf(__expf(xx)); g = -__expf(p.in[10][l * 4 + h]) * sp; }
        float gc = g;
#pragma unroll
        for (int off = 1; off < 64; off <<= 1) { const float tv = __shfl_up(gc, off); if (lane >= off) gc += tv; }
        GC[i] = gc; BE[i] = be; EG[i] = __expf(gc);
        if (lane == 63) *(float*)(item + IT_GL) = __expf(gc);
    }
#pragma unroll 1
    for (int part = 0; part < 3; ++part) {
        const int pc = part * 512 + h * 128 + col;
        const float w0 = cqw[pc], w1 = cqw[1536 + pc], w2 = cqw[2 * 1536 + pc], w3 = cqw[3 * 1536 + pc];
        float x0, x1, x2;
        {
            const int i0 = rq * 16;
            float hv[3];
#pragma unroll
            for (int j = 0; j < 3; ++j) { const int i = i0 - 3 + j; float v = 0.f;
                if (i >= 0) { if (i < nvalid) v = bf2f(P[(size_t)(r0 + i) * LDP + C_QKV + pc]); }
                else if (hist_proj) v = bf2f(P[(size_t)(r0 + i) * LDP + C_QKV + pc]);
                else if (smp) v = scq[(size_t)(3 + i) * 1536 + pc];
                hv[j] = v; }
            x0 = hv[0]; x1 = hv[1]; x2 = hv[2];
        }
#pragma unroll
        for (int ii = 0; ii < 16; ++ii) { const int i = rq * 16 + ii; float x3 = 0.f; if (i < nvalid) x3 = bf2f(P[(size_t)(r0 + i) * LDP + C_QKV + pc]);
            const float y = w0 * x0 + w1 * x1 + w2 * x2 + w3 * x3; float s = y * sigm(y); if (i >= nvalid) s = 0.f;
            SCR[i * 132 + col] = s; x0 = x1; x1 = x2; x2 = x3; }
        lds_barrier();
        if (part < 2) {
            const int row = tid >> 3, pt = tid & 7; float ssum = 0.f;
#pragma unroll
            for (int e = 0; e < 16; ++e) { const float v = SCR[row * 132 + pt * 16 + e]; ssum += v * v; }
            ssum += __shfl_xor(ssum, 1); ssum += __shfl_xor(ssum, 2); ssum += __shfl_xor(ssum, 4);
            if (pt == 0) RN[row] = rsqrtf(ssum + EPS) * (part == 0 ? 0.08838834764831845f : 1.0f);
            lds_barrier();
        }
        LAS bf16_t* dst = part == 0 ? QB : (part == 1 ? KB : VB);
#pragma unroll
        for (int ii = 0; ii < 16; ++ii) { const int i = rq * 16 + ii; float v = SCR[i * 132 + col]; if (part < 2) v *= RN[i]; dst[i * 136 + col] = (bf16_t)f2bf(v); }
        lds_barrier();
    }
    {
        bf16_t* PPg = (bf16_t*)(item + IT_PP);
#pragma unroll 1
        for (int jj = 0; jj < 4; ++jj) { const int job = wave * 4 + jj, which = job >> 4, ti = (job & 15) >> 2, tj = job & 3;
            f32x4 acc = {0.f, 0.f, 0.f, 0.f};
            if (tj <= ti) {
                const LAS bf16_t* Asrc = which ? QB : KB;
#pragma unroll
                for (int kk = 0; kk < 4; ++kk) { const bf16x8 a = *(const LAS bf16x8*)(Asrc + (16 * ti + (lane & 15)) * 136 + 32 * kk + 8 * (lane >> 4));
                    const bf16x8 b = *(const LAS bf16x8*)(KB + (16 * tj + (lane & 15)) * 136 + 32 * kk + 8 * (lane >> 4));
                    acc = __builtin_amdgcn_mfma_f32_16x16x32_bf16(a, b, acc, 0, 0, 0); }
            }
            const int j = 16 * tj + (lane & 15);
#pragma unroll
            for (int e = 0; e < 4; ++e) { const int i = 16 * ti + 4 * (lane >> 4) + e;
                const float dec = (j <= i) ? __expf(GC[i] - GC[j]) : 0.f;
                if (which == 0) AM[j * 68 + i] = (j < i) ? acc[e] * dec * BE[i] : 0.f;
                else PPg[i * 64 + perm16(j)] = (bf16_t)f2bf(acc[e] * dec); }
        }
    }
    lds_barrier();
    if (tid < 256) {
        const int c = tid; LAS float* SOL = (LAS float*)(lds + L_SOL);
        bf16_t* WV = (bf16_t*)(item + IT_WV); bf16_t* WK = (bf16_t*)(item + IT_WK);
#pragma unroll 1
        for (int rb = 0; rb < 4; ++rb) {
            float s[16];
#pragma unroll
            for (int ii = 0; ii < 16; ++ii) { const int i = 16 * rb + ii; s[ii] = (c < 128) ? bf2f(VB[i * 136 + c]) * BE[i] : bf2f(KB[i * 136 + (c - 128)]) * BE[i] * EG[i]; }
#pragma unroll 2
            for (int j = 0; j < 16 * rb; ++j) { const float x = SOL[j * 256 + c];
#pragma unroll
                for (int q4 = 0; q4 < 4; ++q4) { const f32x4 a = *(const LAS f32x4*)(AM + j * 68 + 16 * rb + 4 * q4);
#pragma unroll
                    for (int e = 0; e < 4; ++e) s[4 * q4 + e] -= a[e] * x; } }
#pragma unroll
            for (int jj = 0; jj < 15; ++jj) {
#pragma unroll
                for (int q4 = 0; q4 < 4; ++q4) { if (4 * q4 + 3 > jj) { const f32x4 a = *(const LAS f32x4*)(AM + (16 * rb + jj) * 68 + 16 * rb + 4 * q4);
#pragma unroll
                    for (int e = 0; e < 4; ++e) if (4 * q4 + e > jj) s[4 * q4 + e] -= a[e] * s[jj]; } } }
            if (rb < 3) {
#pragma unroll
                for (int ii = 0; ii < 16; ++ii) SOL[(16 * rb + ii) * 256 + c] = s[ii]; }
            if (c < 128) { const int w = c >> 5, cc = c & 31;
#pragma unroll
                for (int ii = 0; ii < 16; ++ii) { const int i = 16 * rb + ii; const int mt = i >> 5, i5 = i & 31, hi = (i5 >> 2) & 1, idx = 4 * (i5 >> 3) + (i5 & 3);
                    WV[((w * 2 + mt) * 64 + cc + 32 * hi) * 16 + idx] = (bf16_t)f2bf(s[ii]); } }
            else { const int k = perm16(c - 128);
#pragma unroll
                for (int ii = 0; ii < 16; ++ii) WK[(16 * rb + ii) * 128 + k] = (bf16_t)f2bf(-s[ii]); }
        }
    } else {
        const int t2 = tid - 256; bf16_t* QG = (bf16_t*)(item + IT_QG); bf16_t* KT = (bf16_t*)(item + IT_KT); const float gce = GC[63];
#pragma unroll 4
        for (int it = 0; it < 32; ++it) { const int e = t2 + 256 * it; const int i = e >> 7, k = e & 127; QG[i * 128 + perm16(k)] = (bf16_t)f2bf(bf2f(QB[i * 136 + k]) * EG[i]); }
#pragma unroll 4
        for (int it = 0; it < 32; ++it) { const int e = t2 + 256 * it; const int k = e >> 6, c = e & 63; KT[k * 64 + perm16(c)] = (bf16_t)f2bf(bf2f(KB[c * 136 + k]) * __expf(gce - GC[c])); }
    }
    lds_barrier();
}

constexpr int B_WK = 0, B_QG = 17408, B_KT = 34816, B_PP = 53248, B_SZ = 62464, L_STG = 2 * B_SZ, STG_P = 68, STG_SZ = 128 * STG_P * 2;
DI bf16x8 pack8(const f32x16& v, int o) {
    u32x4 w; w.x = pk2(v[o + 0], v[o + 1]); w.y = pk2(v[o + 2], v[o + 3]); w.z = pk2(v[o + 4], v[o + 5]); w.w = pk2(v[o + 6], v[o + 7]);
    return __builtin_bit_cast(bf16x8, w);
}
DI void onorm_pass(const Params& p, int l, LAS unsigned char* lds, int tp0, int tp1, int stride) {
    const int tid = otid();
    bf16_t* P = (bf16_t*)(p.ws + WS_P); const float* og = p.in[12] + l * 128;
    LAS bf16_t* tl = (LAS bf16_t*)lds;
    const int half = tid >> 8, t2 = tid & 255, row = t2 >> 2, q = t2 & 3;
    LAS bf16_t* mine = tl + half * (128 * STG_P);
    for (int tp = tp0; tp < tp1; tp += stride) {
        const int tile = tp * 2 + half;
        const unsigned char* src = (const unsigned char*)p.out + OUT_OT + (size_t)tile * 16384;
        u32x4 ldv[4];
#pragma unroll
        for (int k = 0; k < 4; ++k) ldv[k] = *(const u32x4*)(src + (t2 + 256 * k) * 16);
#pragma unroll
        for (int k = 0; k < 4; ++k) { const int j = t2 + 256 * k; LAS u32x2* d2 = (LAS u32x2*)((LAS unsigned char*)mine + (j >> 3) * (STG_P * 2) + (j & 7) * 16);
            d2[0] = (u32x2){ldv[k].x, ldv[k].y}; d2[1] = (u32x2){ldv[k].z, ldv[k].w}; }
        lds_barrier();
        const bool smp = tile >= 1024; int r, h; bool rvalid;
        if (!smp) { const int chain = tile >> 7, n = tile & 127; h = chain & 3; r = (chain >> 2) * SEQ + n * 64 + row; rvalid = true; }
        else { const int c = tile - 1024; h = c & 3; r = TP + (c >> 2) * DSEQ + row; rvalid = row < DSEQ; }
        float v[32]; float ssum = 0.f;
#pragma unroll
        for (int e = 0; e < 32; ++e) { v[e] = bf2f(mine[((e >> 3) * 32 + q * 8 + (e & 7)) * STG_P + row]); ssum += v[e] * v[e]; }
        ssum += __shfl_xor(ssum, 1); ssum += __shfl_xor(ssum, 2);
        const float rs = rsqrtf(ssum * (1.0f / 128.0f) + EPS);
        if (rvalid) { bf16_t* zp = P + (size_t)r * LDP + C_Z + h * 128 + q * 8;
#pragma unroll
            for (int e = 0; e < 4; ++e) { const u32x4 z = *(const u32x4*)(zp + e * 32); const float zz[8] = {bflo(z.x), bfhi(z.x), bflo(z.y), bfhi(z.y), bflo(z.z), bfhi(z.z), bflo(z.w), bfhi(z.w)}; float o[8];
#pragma unroll
                for (int k = 0; k < 8; ++k) o[k] = v[8 * e + k] * rs * og[e * 32 + q * 8 + k] * zz[k];
                u32x4 w; w.x = pk2(o[0], o[1]); w.y = pk2(o[2], o[3]); w.z = pk2(o[4], o[5]); w.w = pk2(o[6], o[7]); *(u32x4*)(zp + e * 32) = w; } }
        lds_barrier();
    }
}
DI void scan_chain(const Params& p, int l, bool smp, int chain, int n0, int nsteps, const unsigned char* items, bool first_seg, bool last_seg, LAS unsigned char* lds, bool dry) {
    const int tid = otid(), lane = tid & 63, wave = __builtin_amdgcn_readfirstlane(tid >> 6);
    const int h = chain & 3, bb = chain >> 2;
    const int nvalid = smp ? DSEQ : 64;
    bf16_t* P = (bf16_t*)(p.ws + WS_P);
    if (wave < 4) {
        const int cl = lane & 31, hi = lane >> 5, vcol = wave * 32 + cl;
        f32x16 S[4];
        float* sbuf = (float*)(p.ws + WS_SB) + (size_t)chain * 16384;
        if (smp) { const float* s0 = p.in[4] + (((size_t)l * DB + bb) * 4 + h) * 16384;
#pragma unroll
            for (int t = 0; t < 4; ++t)
#pragma unroll
                for (int i = 0; i < 16; ++i) S[t][i] = s0[(32 * t + 8 * (i >> 2) + 4 * hi + (i & 3)) * 128 + vcol]; }
        else if (first_seg) {
#pragma unroll
            for (int t = 0; t < 4; ++t)
#pragma unroll
                for (int i = 0; i < 16; ++i) S[t][i] = 0.f; }
        else {
#pragma unroll
            for (int t = 0; t < 4; ++t)
#pragma unroll
                for (int i = 0; i < 16; ++i) S[t][i] = sbuf[((wave * 4 + t) * 16 + i) * 64 + lane]; }
        u32x4 wvA[4], wvB[4]; float glA = 1.f, glB = 1.f;
        { const u32x4* wv = (const u32x4*)(items + IT_WV) + ((wave * 2) * 64 + lane) * 2;
            wvA[0] = wv[0]; wvA[1] = wv[1]; wvA[2] = wv[128]; wvA[3] = wv[129]; glA = *(const float*)(items + IT_GL); }
#pragma unroll
        for (int e = 0; e < 4; ++e) wvB[e] = (u32x4){0u, 0u, 0u, 0u};
        if (nsteps > 1) { const unsigned char* itp = items + ITEM_BYTES; const u32x4* wv = (const u32x4*)(itp + IT_WV) + ((wave * 2) * 64 + lane) * 2;
            wvB[0] = wv[0]; wvB[1] = wv[1]; wvB[2] = wv[128]; wvB[3] = wv[129]; glB = *(const float*)(itp + IT_GL); }
        lds_barrier();
#pragma unroll 1
        for (int s = 0; s < nsteps; ++s) {
            const LAS unsigned char* B = lds + (s & 1) * B_SZ;
            f32x16 U[2], O[2]; float gl;
#define SC_UNPACK(WV) do { _Pragma("unroll") for (int mt = 0; mt < 2; ++mt) { const u32x4 a = WV[2 * mt], b = WV[2 * mt + 1]; \
                U[mt][0] = bflo(a.x); U[mt][1] = bfhi(a.x); U[mt][2] = bflo(a.y); U[mt][3] = bfhi(a.y); U[mt][4] = bflo(a.z); U[mt][5] = bfhi(a.z); U[mt][6] = bflo(a.w); U[mt][7] = bfhi(a.w); \
                U[mt][8] = bflo(b.x); U[mt][9] = bfhi(b.x); U[mt][10] = bflo(b.y); U[mt][11] = bfhi(b.y); U[mt][12] = bflo(b.z); U[mt][13] = bfhi(b.z); U[mt][14] = bflo(b.w); U[mt][15] = bfhi(b.w); } } while (0)
#define SC_WVLOAD(WV, GL) do { const unsigned char* itp = items + (size_t)(s + 2) * ITEM_BYTES; const u32x4* wv = (const u32x4*)(itp + IT_WV) + ((wave * 2) * 64 + lane) * 2; \
                WV[0] = wv[0]; WV[1] = wv[1]; WV[2] = wv[128]; WV[3] = wv[129]; GL = *(const float*)(itp + IT_GL); } while (0)
            if (s & 1) { SC_UNPACK(wvB); gl = glB; if (s + 2 < nsteps) SC_WVLOAD(wvB, glB); }
            else { SC_UNPACK(wvA); gl = glA; if (s + 2 < nsteps) SC_WVLOAD(wvA, glA); }
#pragma unroll
            for (int mt = 0; mt < 2; ++mt)
#pragma unroll
                for (int i = 0; i < 16; ++i) O[mt][i] = 0.f;
            bf16x8 A0[6], A1[6];
#define SC_SB() __builtin_amdgcn_sched_barrier(0)
#define SC_LD1(dst, blk) do { const int ko_ = (16 * (blk) + 8 * hi) * 2; \
                dst[0] = *(const LAS bf16x8*)(B + B_WK + cl * 272 + ko_); dst[1] = *(const LAS bf16x8*)(B + B_WK + (32 + cl) * 272 + ko_); \
                dst[2] = *(const LAS bf16x8*)(B + B_QG + cl * 272 + ko_); dst[3] = *(const LAS bf16x8*)(B + B_QG + (32 + cl) * 272 + ko_); } while (0)
#define SC_LD2(dst, blk) do { const int ko_ = (16 * (blk) + 8 * hi) * 2; \
                dst[0] = *(const LAS bf16x8*)(B + B_KT + cl * 144 + ko_); dst[1] = *(const LAS bf16x8*)(B + B_KT + (32 + cl) * 144 + ko_); \
                dst[2] = *(const LAS bf16x8*)(B + B_KT + (64 + cl) * 144 + ko_); dst[3] = *(const LAS bf16x8*)(B + B_KT + (96 + cl) * 144 + ko_); \
                dst[4] = *(const LAS bf16x8*)(B + B_PP + cl * 144 + ko_); dst[5] = *(const LAS bf16x8*)(B + B_PP + (32 + cl) * 144 + ko_); } while (0)
#define SC_MM1(src, blk) do { const bf16x8 Sbk = pack8(S[(blk) >> 1], ((blk) & 1) * 8); \
                U[0] = __builtin_amdgcn_mfma_f32_32x32x16_bf16(src[0], Sbk, U[0], 0, 0, 0); O[0] = __builtin_amdgcn_mfma_f32_32x32x16_bf16(src[2], Sbk, O[0], 0, 0, 0); \
                U[1] = __builtin_amdgcn_mfma_f32_32x32x16_bf16(src[1], Sbk, U[1], 0, 0, 0); O[1] = __builtin_amdgcn_mfma_f32_32x32x16_bf16(src[3], Sbk, O[1], 0, 0, 0); } while (0)
#define SC_MM2(src, blk) do { const bf16x8 Ubk = pack8(U[(blk) >> 1], ((blk) & 1) * 8); \
                S[0] = __builtin_amdgcn_mfma_f32_32x32x16_bf16(src[0], Ubk, S[0], 0, 0, 0); S[1] = __builtin_amdgcn_mfma_f32_32x32x16_bf16(src[1], Ubk, S[1], 0, 0, 0); \
                S[2] = __builtin_amdgcn_mfma_f32_32x32x16_bf16(src[2], Ubk, S[2], 0, 0, 0); S[3] = __builtin_amdgcn_mfma_f32_32x32x16_bf16(src[3], Ubk, S[3], 0, 0, 0); \
                O[0] = __builtin_amdgcn_mfma_f32_32x32x16_bf16(src[4], Ubk, O[0], 0, 0, 0); O[1] = __builtin_amdgcn_mfma_f32_32x32x16_bf16(src[5], Ubk, O[1], 0, 0, 0); } while (0)
            SC_LD1(A0, 0); SC_SB();
            SC_LD1(A1, 1); SC_SB(); SC_MM1(A0, 0); SC_SB();
            SC_LD1(A0, 2); SC_SB(); SC_MM1(A1, 1); SC_SB();
            SC_LD1(A1, 3); SC_SB(); SC_MM1(A0, 2); SC_SB();
            SC_LD1(A0, 4); SC_SB(); SC_MM1(A1, 3); SC_SB();
            SC_LD1(A1, 5); SC_SB(); SC_MM1(A0, 4); SC_SB();
            SC_LD1(A0, 6); SC_SB(); SC_MM1(A1, 5); SC_SB();
            SC_LD1(A1, 7); SC_SB(); SC_MM1(A0, 6); SC_SB();
            SC_LD2(A0, 0); SC_SB(); SC_MM1(A1, 7); SC_SB();
#pragma unroll
            for (int t = 0; t < 4; ++t) S[t] = S[t] * gl;
            SC_SB();
            SC_LD2(A1, 1); SC_SB(); SC_MM2(A0, 0); SC_SB();
            SC_LD2(A0, 2); SC_SB(); SC_MM2(A1, 1); SC_SB();
            SC_LD2(A1, 3); SC_SB(); SC_MM2(A0, 2); SC_SB();
            SC_MM2(A1, 3); SC_SB();
            LAS bf16_t* stg = (LAS bf16_t*)(lds + L_STG + (s & 1) * STG_SZ);
#pragma unroll
            for (int mt = 0; mt < 2; ++mt)
#pragma unroll
                for (int a4 = 0; a4 < 4; ++a4) { u32x2 w; w.x = pk2(O[mt][4 * a4 + 0], O[mt][4 * a4 + 1]); w.y = pk2(O[mt][4 * a4 + 2], O[mt][4 * a4 + 3]);
                    *(LAS u32x2*)(stg + vcol * STG_P + 32 * mt + 8 * a4 + 4 * hi) = w; }
            lds_barrier();
        }
        lds_barrier();
        int vcol2 = vcol, hi2 = hi, lane2 = lane; asm volatile("" : "+v"(vcol2), "+v"(hi2), "+v"(lane2));
        if (dry) {} else if (smp || last_seg) { float* so = smp ? p.out + O_SS + (((size_t)l * DB + bb) * 4 + h) * 16384 : p.out + O_PS + (((size_t)l * 2 + bb) * 4 + h) * 16384;
#pragma unroll
            for (int t = 0; t < 4; ++t)
#pragma unroll
                for (int i = 0; i < 16; ++i) so[(32 * t + 8 * (i >> 2) + 4 * hi2 + (i & 3)) * 128 + vcol2] = S[t][i]; }
        else {
#pragma unroll
            for (int t = 0; t < 4; ++t)
#pragma unroll
                for (int i = 0; i < 16; ++i) sbuf[((wave * 4 + t) * 16 + i) * 64 + lane2] = S[t][i]; }
    } else {
        const int t2 = tid - 256;
        u32x4 ld[14];
#define SC_ISSUE(s_) do { const u32x4* src_ = (const u32x4*)(items + (size_t)(s_) * ITEM_BYTES); _Pragma("unroll") for (int it = 0; it < 14; ++it) ld[it] = src_[t2 + 256 * it]; } while (0)
#define SC_COMMIT(s_) do { LAS unsigned char* B_ = lds + ((s_) & 1) * B_SZ; _Pragma("unroll") for (int it = 0; it < 14; ++it) *(LAS u32x4*)(B_ + dsto[it]) = ld[it]; } while (0)
        unsigned char* otile0 = (unsigned char*)p.out + OUT_OT + (size_t)(smp ? 1024 + chain : chain * 128 + n0) * 16384;
        int dsto[14];
#pragma unroll
        for (int it = 0; it < 14; ++it) { const int off = (t2 + 256 * it) * 16; int dst;
            if (off < 32768) { const int o2 = off & 16383; dst = (off < 16384 ? B_WK : B_QG) + (o2 >> 8) * 272 + (o2 & 255); }
            else if (off < 49152) { const int o2 = off - 32768; dst = B_KT + (o2 >> 7) * 144 + (o2 & 127); }
            else { const int o2 = off - 49152; dst = B_PP + (o2 >> 7) * 144 + (o2 & 127); }
            dsto[it] = dst; }
#define SC_OCOPY(sp_) do { if (!dry) { const LAS unsigned char* stg_ = lds + L_STG + ((sp_) & 1) * STG_SZ; unsigned char* ot_ = otile0 + (size_t)(sp_) * 16384; \
            _Pragma("unroll") for (int k = 0; k < 4; ++k) { const int j = t2 + 256 * k; const LAS u32x2* sp2 = (const LAS u32x2*)(stg_ + (j >> 3) * (STG_P * 2) + (j & 7) * 16); \
                const u32x2 lo = sp2[0], hi2 = sp2[1]; *(u32x4*)(ot_ + j * 16) = (u32x4){lo.x, lo.y, hi2.x, hi2.y}; } } } while (0)
        u32x4 ldB[14];
#define SC_ISSUE2(LD, s_) do { const u32x4* src_ = (const u32x4*)(items + (size_t)(s_) * ITEM_BYTES); _Pragma("unroll") for (int it = 0; it < 14; ++it) LD[it] = src_[t2 + 256 * it]; } while (0)
#define SC_COMMIT2(LD, s_) do { LAS unsigned char* B_ = lds + ((s_) & 1) * B_SZ; _Pragma("unroll") for (int it = 0; it < 14; ++it) *(LAS u32x4*)(B_ + dsto[it]) = LD[it]; } while (0)
        SC_ISSUE2(ld, 0); SC_COMMIT2(ld, 0);
        if (nsteps > 1) SC_ISSUE2(ld, 1);
        if (nsteps > 2) SC_ISSUE2(ldB, 2);
        lds_barrier();
#pragma unroll 1
        for (int s = 0; s < nsteps; s += 2) {
            if (s + 1 < nsteps) SC_COMMIT2(ld, s + 1);
            if (s + 3 < nsteps) SC_ISSUE2(ld, s + 3);
            if (s > 0) SC_OCOPY(s - 1);
            lds_barrier();
            if (s + 1 >= nsteps) break;
            if (s + 2 < nsteps) SC_COMMIT2(ldB, s + 2);
            if (s + 4 < nsteps) SC_ISSUE2(ldB, s + 4);
            SC_OCOPY(s);
            lds_barrier();
        }
        SC_OCOPY(nsteps - 1);
        lds_barrier();
    }
}

DI void sample_fix(const Params& p, ssq_t* ss) {
    const int tid_ = otid(), lane = tid_ & 63, gw = blockIdx.x * 8 + __builtin_amdgcn_readfirstlane(tid_ >> 6), ngw = gridDim.x * 8;
    const float* part = (const float*)(p.ws + WS_PART); bf16_t* AB = (bf16_t*)(p.ws + WS_AB);
    for (int rr = gw; rr < TS; rr += ngw) { const int r = TP + rr; u32x2* xb2 = (u32x2*)(AB + (size_t)r * D); float s = 0.f;
#pragma unroll
        for (int j = 0; j < 4; ++j) { const u32x2 w0 = xb2[lane + 64 * j]; f32x4 v = {bflo(w0.x), bfhi(w0.x), bflo(w0.y), bfhi(w0.y)};
#pragma unroll
            for (int k = 0; k < 8; ++k) v += *((const f32x4*)(part + ((size_t)k * TS + rr) * D) + lane + 64 * j);
            s += (v[0] * v[0] + v[1] * v[1]) + (v[2] * v[2] + v[3] * v[3]);
            u32x2 w; w.x = pk2(v[0], v[1]); w.y = pk2(v[2], v[3]); xb2[lane + 64 * j] = w; }
#pragma unroll
        for (int o = 1; o < 64; o <<= 1) s += __shfl_xor(s, o);
        if (lane == 0) ss[r] = ss_fix(s); }
}
constexpr int CV_EARLY = 16 * 112 + 16 * 32 + 16 * 32 + 8 * 32 + 8 * 32, CV_MID = CV_EARLY + 16 * 32 + 16 * 128, CV_ALL = CV_MID + 64 * 32;
__global__ void __launch_bounds__(512, 2) mega_fwd(Params p) {
    extern __shared__ __attribute__((aligned(16))) unsigned char lds_raw[];
    LAS unsigned char* lds = (LAS unsigned char*)lds_raw;
    cg::grid_group grid = cg::this_grid();
    const int G = gridDim.x, bx = blockIdx.x;
    if (threadIdx.x < 16) ((LAS unsigned*)(lds + L_BARST))[threadIdx.x] = 0u;
    __syncthreads();
    if (p.ws == nullptr) grid.sync();
    const XcdBarrier xbar = xcd_barrier_post((unsigned*)(p.ws + WS_CTL + CTL_BAR), (volatile LAS unsigned*)(lds + L_BARST));
#define GSYNC() xcd_barrier(xbar)
    unsigned char* ws = p.ws;
    ssq_t* SS = (ssq_t*)(ws + WS_CTL);
    bf16_t* AB = (bf16_t*)(ws + WS_AB); bf16_t* PJ = (bf16_t*)(ws + WS_P); bf16_t* MX = PJ + C_CA;
    float* BG = (float*)(ws + WS_BG);
    unsigned char* W = ws + WS_W;

    { const int tid_ = otid(), lane = tid_ & 63, gw = bx * 8 + __builtin_amdgcn_readfirstlane(tid_ >> 6), ngw = G * 8;
    for (int r = gw; r < T; r += ngw) { const float* xr = (r < TP) ? p.in[0] + (size_t)r * D : p.in[1] + (size_t)(r - TP) * D; float s = 0.f;
#pragma unroll
        for (int j = 0; j < 4; ++j) { const f32x4 v = *((const f32x4*)xr + lane + 64 * j); s += (v[0] * v[0] + v[1] * v[1]) + (v[2] * v[2] + v[3] * v[3]);
            u32x2 w; w.x = pk2(v[0], v[1]); w.y = pk2(v[2], v[3]); *((u32x2*)(AB + (size_t)r * D) + lane + 64 * j) = w; }
#pragma unroll
        for (int o = 1; o < 64; o <<= 1) s += __shfl_xor(s, o);
        if (lane == 0) SS[r] = ss_fix(s); } }

#pragma unroll 1
    for (int l = 0; l < 2; ++l) {
        ssq_t* ss1 = SS + (size_t)(2 * l) * T; ssq_t* ss2 = SS + (size_t)(2 * l + 1) * T; ssq_t* ss3 = SS + (size_t)(2 * l + 2) * T;
        if (l == 1 && G == 256) convert_weights(p, l, lds, CV_MID, CV_ALL, false, bx * 8, G * 8);
        else convert_weights(p, l, lds, 0, CV_ALL, true, bx * 8, G * 8);
        GSYNC();
        {
            pg8::Gemm g{AB, (const bf16_t*)(W + W_IN), T, 3840, D, D, D}; pg8::StaticOrder S; S.init(T, 3840, G, bx);
            EpiB<0> E{PJ, LDP, ss1, BG, nullptr, 0};
            pg8::gemm_phase<EpiB<0>, true>(lds, g, S, E);
        }
        GSYNC();
        {
            unsigned char* items0 = ws + WS_PRE;
            unsigned char* items1 = (unsigned char*)p.out;
#pragma unroll 1
            for (int pass = 0; pass < 2; ++pass) {
                if ((pass == 0) == ((bx & 1) != 0)) mixer_a_phase(p, l);
                else for (int it = bx; it < 512; it += G) chunk_item(p, l, false, it >> 6, it & 63, items0 + (size_t)it * ITEM_BYTES, lds);
            }
            GSYNC();
            if (bx < 8) scan_chain(p, l, false, bx, 0, 64, items0 + (size_t)bx * 64 * ITEM_BYTES, true, false, lds, false);
            else {
                for (int c = bx - 8; c < 128; c += G - 8) {
                    chunk_item(p, l, true, c, 0, items0 + (size_t)(512 + c) * ITEM_BYTES, lds);
                    __threadfence(); __syncthreads();
                    scan_chain(p, l, true, c, 0, 1, items0 + (size_t)(512 + c) * ITEM_BYTES, true, true, lds, false);
                }
                if (G == 256) {
                    if (bx >= 136) { for (int k = 0; k < 3; ++k) { const int it = (bx - 136) + 120 * k; chunk_item(p, l, false, it >> 6, 64 + (it & 63), items1 + (size_t)it * ITEM_BYTES, lds); } }
                    else { { const int it = 360 + (bx - 8); chunk_item(p, l, false, it >> 6, 64 + (it & 63), items1 + (size_t)it * ITEM_BYTES, lds); }
                        if (bx - 8 < 24) { const int it = 488 + (bx - 8); chunk_item(p, l, false, it >> 6, 64 + (it & 63), items1 + (size_t)it * ITEM_BYTES, lds); } }
                } else { for (int it = bx - 8; it < 512; it += G - 8) chunk_item(p, l, false, it >> 6, 64 + (it & 63), items1 + (size_t)it * ITEM_BYTES, lds); }
                if (G == 256) { const int b2 = bx - 8;
                    if (b2 >= 24 && b2 < 128) { pg8::ListOrder S{1, b2 - 24, 0, T / 256, D / 256};
                        pg8::Gemm g{AB, (const bf16_t*)(W + W_IN) + (size_t)R_GA * D, T, D, D, D, D}; EpiB<2> E{MX, LDP, ss1, nullptr, nullptr, 0}; pg8::gemm_phase<EpiB<2>, true, pg8::ListOrder>(lds, g, S, E); }
                } else { pg8::StaticOrder S; S.init(T, D, G - 8, bx - 8);
                    pg8::Gemm g{AB, (const bf16_t*)(W + W_IN) + (size_t)R_GA * D, T, D, D, D, D}; EpiB<2> E{MX, LDP, ss1, nullptr, nullptr, 0}; pg8::gemm_phase<EpiB<2>, true>(lds, g, S, E); }
            }
            GSYNC();
            if (bx < 8) scan_chain(p, l, false, bx, 64, 64, items1 + (size_t)bx * 64 * ITEM_BYTES, false, true, lds, false);
            else if (G == 256) {
                const int b2 = bx - 8; const int nM = T / 256, nN = D / 256;
                const pg8::Gemm gga{AB, (const bf16_t*)(W + W_IN) + (size_t)R_GA * D, T, D, D, D, D}, gya{PJ + C_BA, (const bf16_t*)(W + W_A), T, D, 512, LDP, 512},
                                ggb{AB, (const bf16_t*)(W + W_IN) + (size_t)R_GB * D, T, D, D, D, D};
                const EpiB<2> Ega{MX, LDP, ss1, nullptr, nullptr, 0}; const EpiB<3> Eya{MX, LDP, nullptr, nullptr, nullptr, 0}; const EpiB<2> Egb{PJ + C_QKV, LDP, ss1, nullptr, nullptr, 0};
                { pg8::ListOrder S{b2 < 160 ? 1 : 0, 104 + b2, 0, nM, nN}; pg8::gemm_phase<EpiB<2>, true, pg8::ListOrder>(lds, gga, S, Ega); }
                { pg8::ListOrder S{1, 0, 0, nM, nN}; if (b2 < 160) { S.u0 = 104 + b2; if (b2 < 16) { S.n = 2; S.u1 = 88 + b2; } } else S.u0 = b2 - 160;
                  pg8::gemm_phase<EpiB<3>, true, pg8::ListOrder>(lds, gya, S, Eya); }
                { pg8::ListOrder S{0, 0, 0, nM, nN}; if (b2 >= 160) { S.n = 2; S.u0 = 2 * (b2 - 160); S.u1 = S.u0 + 1; } else if (b2 >= 16 && b2 < 104) { S.n = 1; S.u0 = 176 + (b2 - 16); }
                  pg8::gemm_phase<EpiB<2>, true, pg8::ListOrder>(lds, ggb, S, Egb); }
                if (b2 >= 104 && b2 < 160) onorm_pass(p, l, lds, 512 + (b2 - 104), 576, 56);
            } else {
                pg8::StaticOrder S; S.init(T, D, G - 8, bx - 8);
                { pg8::Gemm g{PJ + C_BA, (const bf16_t*)(W + W_A), T, D, 512, LDP, 512}; EpiB<3> E{MX, LDP, nullptr, nullptr, nullptr, 0}; pg8::gemm_phase<EpiB<3>, true>(lds, g, S, E); }
                { pg8::Gemm g{AB, (const bf16_t*)(W + W_IN) + (size_t)R_GB * D, T, D, D, D, D}; EpiB<2> E{PJ + C_QKV, LDP, ss1, nullptr, nullptr, 0}; pg8::gemm_phase<EpiB<2>, true>(lds, g, S, E); }
            }
            GSYNC();
        }
        if (G == 256) {
            if (bx >= 8) onorm_pass(p, l, lds, bx - 8, 512, 248);
            else { pg8::UnitOrder S{1, TP / 256 + (bx >> 2), bx & 3};
                pg8::Gemm g{PJ + C_Z, (const bf16_t*)(W + W_B), T, D, 512, LDP, 512}; EpiB<4> E{MX, LDP, nullptr, nullptr, PJ + C_QKV, LDP}; pg8::gemm_phase<EpiB<4>, true, pg8::UnitOrder>(lds, g, S, E); }
        } else onorm_pass(p, l, lds, bx, 576, G);
        GSYNC();
        {
            const int Myb = (G == 256) ? TP : T;
            pg8::StaticOrder S; S.init(Myb, D, G, bx);
            { pg8::Gemm g{PJ + C_Z, (const bf16_t*)(W + W_B), Myb, D, 512, LDP, 512}; EpiB<4> E{MX, LDP, nullptr, nullptr, PJ + C_QKV, LDP}; pg8::gemm_phase<EpiB<4>, true>(lds, g, S, E); }
        }
        GSYNC();
        if (G == 256) {
            unsigned* flag = (unsigned*)(ws + WS_CTL + 900 * 1024) + 64 * l;
            const pg8::Gemm g3{MX, (const bf16_t*)(W + W_O), T, D, D, LDP, D}; const EpiRes E3{AB, ss2};
            if (bx < 8) {
                pg8::UnitOrder Su{1, TP / 256 + (bx >> 2), bx & 3};
                pg8::gemm_phase<EpiRes, true, pg8::UnitOrder>(lds, g3, Su, E3);
                __syncthreads();
                if (threadIdx.x == 0) { __builtin_amdgcn_fence(__ATOMIC_RELEASE, "agent"); asm volatile("s_waitcnt vmcnt(0)" ::: "memory");
                    __hip_atomic_fetch_add(flag, 1u, __ATOMIC_RELAXED, __HIP_MEMORY_SCOPE_AGENT); }
            }
            { pg8::StaticOrder S; S.init(TP, D, G, bx); pg8::gemm_phase<EpiRes, true>(lds, g3, S, E3); }
            if (bx >= 8 && bx < 40) {
                if (threadIdx.x == 0) { unsigned sp = 0;
                    while (__hip_atomic_load(flag, __ATOMIC_RELAXED, __HIP_MEMORY_SCOPE_AGENT) < 8u) { __builtin_amdgcn_s_sleep(4); if (++sp > (1u << 22)) break; }
                    __builtin_amdgcn_fence(__ATOMIC_ACQUIRE, "agent"); asm volatile("s_waitcnt vmcnt(0)" ::: "memory"); }
                __syncthreads();
                pg8::UnitOrder Su{1, TP / 256 + ((bx - 8) >> 4), (bx - 8) & 15};
                pg8::Gemm g4{AB, (const bf16_t*)(W + W_UP), T, FF, D, D, D}; EpiB<1> E4{PJ, FF, ss2, nullptr, nullptr, 0};
                pg8::gemm_phase<EpiB<1>, true, pg8::UnitOrder>(lds, g4, Su, E4);
            }
            if (l == 0 && bx >= 40) convert_weights(p, 1, lds, 0, CV_EARLY, true, (bx - 40) * 8, (G - 40) * 8);
            GSYNC();
            {
                pg8::Gemm g{AB, (const bf16_t*)(W + W_UP), TP, FF, D, D, D}; pg8::StaticOrder S; S.init(TP, FF, G, bx);
                EpiB<1> E{PJ, FF, ss2, nullptr, nullptr, 0};
                pg8::gemm_phase<EpiB<1>, true>(lds, g, S, E);
            }
            GSYNC();
        } else {
        {
            pg8::Gemm g{MX, (const bf16_t*)(W + W_O), T, D, D, LDP, D}; pg8::StaticOrder S; S.init(T, D, G, bx);
            EpiRes E{AB, ss2};
            pg8::gemm_phase<EpiRes, true>(lds, g, S, E);
        }
        GSYNC();
        {
            pg8::Gemm g{AB, (const bf16_t*)(W + W_UP), T, FF, D, D, D}; pg8::StaticOrder S; S.init(T, FF, G, bx);
            EpiB<1> E{PJ, FF, ss2, nullptr, nullptr, 0};
            pg8::gemm_phase<EpiB<1>, true>(lds, g, S, E);
        }
        GSYNC();
        }
        {
            pg8::Gemm g{PJ, (const bf16_t*)(W + W_DN), TP, D, FF, FF, FF}; pg8::StaticOrder S; S.init(TP, D, G, bx);
            EpiRes E{AB, ss3};
            pg8::gemm_phase<EpiRes, true>(lds, g, S, E);
            pg8::Gemm g2{PJ, (const bf16_t*)(W + W_DN), T, D, 512, FF, FF}; pg8::SplitOrder S2{G, bx, TP / 256, 8, 64};
            EpiPart E2{(float*)(ws + WS_PART)};
            pg8::gemm_phase<EpiPart, true, pg8::SplitOrder>(lds, g2, S2, E2);
            if (l == 0 && G == 256 && bx >= 64) convert_weights(p, 1, lds, CV_EARLY, CV_MID, false, (bx - 64) * 8, (G - 64) * 8);
        }
        GSYNC();
        if (l == 0) sample_fix(p, ss3);
    }
    { const ssq_t* ssf = SS + (size_t)4 * T; const float* fg = p.in[18]; const int tid_ = otid(), lane = tid_ & 63, gw = bx * 8 + __builtin_amdgcn_readfirstlane(tid_ >> 6), ngw = G * 8;
      const float* part = (const float*)(ws + WS_PART);
      for (int r = gw; r < T; r += ngw) { f32x4* xr = (f32x4*)(p.out + (size_t)r * D); const u32x2* xb2 = (const u32x2*)(AB + (size_t)r * D);
          if (r < TP) { const float rs = rstd_of(ssf, r);
#pragma unroll
              for (int j = 0; j < 4; ++j) { const u32x2 w = xb2[lane + 64 * j]; const f32x4 gq = *((const f32x4*)fg + lane + 64 * j);
                  const f32x4 v = {bflo(w.x), bfhi(w.x), bflo(w.y), bfhi(w.y)}; xr[lane + 64 * j] = v * rs * gq; } }
          else { const int rr = r - TP; u32x2 wq[4]; float sq = 0.f;
#pragma unroll
              for (int j = 0; j < 4; ++j) { const u32x2 w0 = xb2[lane + 64 * j]; f32x4 v = {bflo(w0.x), bfhi(w0.x), bflo(w0.y), bfhi(w0.y)};
#pragma unroll
                  for (int k = 0; k < 8; ++k) v += *((const f32x4*)(part + ((size_t)k * TS + rr) * D) + lane + 64 * j);
                  sq += (v[0] * v[0] + v[1] * v[1]) + (v[2] * v[2] + v[3] * v[3]); wq[j].x = pk2(v[0], v[1]); wq[j].y = pk2(v[2], v[3]); }
#pragma unroll
              for (int o = 1; o < 64; o <<= 1) sq += __shfl_xor(sq, o);
              const float rs = rsqrtf((float)ss_fix(sq) * (1.0f / (1024.0f * 16777216.0f)) + EPS);
#pragma unroll
              for (int j = 0; j < 4; ++j) { const f32x4 gq = *((const f32x4*)fg + lane + 64 * j);
                  const f32x4 v = {bflo(wq[j].x), bfhi(wq[j].x), bflo(wq[j].y), bfhi(wq[j].y)}; xr[lane + 64 * j] = v * rs * gq; } } } }
}

extern "C" void kernel_launch(void* const* d_in, const int* in_sizes, int n_in, void* d_out, int out_size, void* d_ws, size_t ws_size, hipStream_t stream) {
    static int grid = 0;
    if (grid == 0) {
        int dev = 0, cus = 0, per_cu = 0;
        hipGetDevice(&dev); hipDeviceGetAttribute(&cus, hipDeviceAttributeMultiprocessorCount, dev);
        hipFuncSetAttribute((const void*)mega_fwd, hipFuncAttributeMaxDynamicSharedMemorySize, LDS_BYTES);
        hipOccupancyMaxActiveBlocksPerMultiprocessor(&per_cu, (const void*)mega_fwd, 512, LDS_BYTES);
        (void)hipGetLastError();
        if (per_cu < 1) per_cu = 1;
        grid = cus;
        if (grid <= 0) grid = 256;
    }
    hipMemsetAsync((char*)d_ws + WS_CTL, 0, CTL_BYTES, stream);
    Params p{};
    for (int i = 0; i < 19; ++i) p.in[i] = (const float*)d_in[i];
    p.out = (float*)d_out; p.ws = (unsigned char*)d_ws;
    void* args[] = {&p};
    hipError_t e = hipLaunchCooperativeKernel((const void*)mega_fwd, dim3(grid), dim3(512), args, LDS_BYTES, stream);
    if (e != hipSuccess) fprintf(stderr, "cooperative launch failed: %s (grid %d)\n", hipGetErrorString(e), grid);
}
```
